# Optimizing an MI355X kernel written in HIP

```python
import math
import jax, jax.numpy as jnp
from jax import lax
import numpy as np

D_MODEL = 1024
BATCH = 2
SEQ = 16384
DEPTH = 1
DEC_BATCH = 16
DEC_SEQ = 64
PAST_LEN = 4096

CHUNK = 64
D_A = D_MODEL
D_B = D_MODEL
D_MIX = D_A + D_B
CONV_A_W = 3
CONV_B_W = 4
SSM_HEADDIM = 64
SSM_HEADS = D_B // SSM_HEADDIM
SSM_GROUPS = 4
D_STATE = 128
D_XBC = D_B + 2 * SSM_GROUPS * D_STATE
SPLITS = [D_A, D_A, D_A, D_A, D_B, D_XBC, SSM_HEADS]
D_IN_PROJ = sum(SPLITS)
EPS = 1e-5

kernel_name = "hybrid_shortconv_ssd_stream_step"


def rmsnorm(x, w):
    xf = x.astype(jnp.float32)
    y = xf * lax.rsqrt(jnp.mean(xf * xf, axis=-1, keepdims=True) + EPS)
    return (y * w.astype(jnp.float32)).astype(x.dtype)


def gated_rmsnorm(y, z, w):
    return rmsnorm(y * jax.nn.silu(z), w)


def causal_dwconv(u, buf, w):
    K = w.shape[0]
    L = u.shape[1]
    up = jnp.concatenate([buf.astype(u.dtype), u], axis=1)
    y = up[:, 0:L] * w[0]
    for k in range(1, K):
        y = y + up[:, k:k + L] * w[k]
    return y, up[:, L:]


def ssd_chunked(x, dt, a, bmat, cmat, s0):
    bsz, L, H, P = x.shape
    G, N = bmat.shape[2], bmat.shape[3]
    Hg = H // G
    pad = (-L) % CHUNK
    f32 = jnp.float32
    x, dt, bmat, cmat = (t.astype(f32) for t in (x, dt, bmat, cmat))
    if pad:
        pw = lambda t: jnp.pad(t, [(0, 0), (0, pad)] + [(0, 0)] * (t.ndim - 2))
        x, dt, bmat, cmat = pw(x), pw(dt), pw(bmat), pw(cmat)
    nc = (L + pad) // CHUNK
    xdt = (x * dt[..., None]).reshape(bsz, nc, CHUNK, G, Hg, P)
    da = (dt * a.astype(f32)).reshape(bsz, nc, CHUNK, G, Hg)
    bm = bmat.reshape(bsz, nc, CHUNK, G, N)
    cm = cmat.reshape(bsz, nc, CHUNK, G, N)
    acum = jnp.cumsum(da, axis=2)
    seg = acum[:, :, :, None] - acum[:, :, None, :]
    causal = jnp.tril(jnp.ones((CHUNK, CHUNK), bool))[:, :, None, None]
    decay = jnp.exp(jnp.where(causal, seg, -jnp.inf))
    cb = jnp.einsum('bcign,bcjgn->bcijg', cm, bm)
    y_diag = jnp.einsum('bcijg,bcijgh,bcjghp->bcighp', cb, decay, xdt)
    decay_end = jnp.exp(acum[:, :, -1:] - acum)
    states = jnp.einsum('bcjgn,bcjgh,bcjghp->bcghpn', bm, decay_end, xdt)
    chunk_decay = jnp.exp(acum[:, :, -1])

    def step(s, inp):
        st, dec = inp
        return s * dec[..., None, None] + st, s

    s_final, s_in = lax.scan(step, s0.astype(f32).reshape(bsz, G, Hg, P, N),
                             (jnp.moveaxis(states, 1, 0), jnp.moveaxis(chunk_decay, 1, 0)))
    s_in = jnp.moveaxis(s_in, 0, 1)
    y_off = jnp.einsum('bcign,bcghpn,bcigh->bcighp', cm, s_in, jnp.exp(acum))
    y = (y_diag + y_off).reshape(bsz, nc * CHUNK, H, P)[:, :L]
    return y, s_final.reshape(bsz, H, P, N)


def mixer_layer(x, c, buf_a, buf_b, s0, w_mod, b_mod, norm_in_w, w_in, conv_a_w, norm_a_w,
                conv_b_w, conv_b_b, dt_bias, a_log, d_skip, norm_b_w, w_out):
    bsz, L, _ = x.shape
    mod = c @ w_mod + b_mod
    shift, scale, gate = jnp.split(mod, 3, axis=-1)
    h = rmsnorm(x, norm_in_w) * (1 + scale[:, None]) + shift[:, None]
    proj = h @ w_in
    idx = list(np.cumsum(SPLITS)[:-1])
    b_gate, c_gate, h_a, g_a, z, xbc_raw, dt_raw = jnp.split(proj, idx, axis=-1)
    u = c_gate * h_a
    conv_u, new_a = causal_dwconv(u, buf_a, conv_a_w)
    y_a = gated_rmsnorm(b_gate * conv_u, g_a, norm_a_w)
    xbc, new_b = causal_dwconv(xbc_raw, buf_b, conv_b_w)
    xbc = jax.nn.silu(xbc + conv_b_b)
    xs, bs, cs = jnp.split(xbc, [D_B, D_B + SSM_GROUPS * D_STATE], axis=-1)
    xs = xs.reshape(bsz, L, SSM_HEADS, SSM_HEADDIM)
    dt = jax.nn.softplus(dt_raw.astype(jnp.float32) + dt_bias.astype(jnp.float32))
    a = -jnp.exp(a_log.astype(jnp.float32))
    y, s_new = ssd_chunked(xs, dt, a,
                           bs.reshape(bsz, L, SSM_GROUPS, D_STATE),
                           cs.reshape(bsz, L, SSM_GROUPS, D_STATE), s0)
    y = y.astype(x.dtype) + d_skip[:, None] * xs
    y_b = gated_rmsnorm(y.reshape(bsz, L, D_B), z, norm_b_w)
    out = jnp.concatenate([y_a, y_b], axis=-1) @ w_out
    return x + gate[:, None] * out, new_a, new_b, s_new.astype(s0.dtype)


def trunk(x, c, sa, sb, ss, w_mod, b_mod, norm_in_w, w_in, conv_a_w, norm_a_w, conv_b_w,
          conv_b_b, dt_bias, a_log, d_skip, norm_b_w, w_out, norm_f_w):
    new_a, new_b, new_s = [], [], []
    for l in range(DEPTH):
        x, na, nb, ns = mixer_layer(x, c, sa[l], sb[l], ss[l], w_mod[l], b_mod[l], norm_in_w[l],
                                    w_in[l], conv_a_w[l], norm_a_w[l], conv_b_w[l], conv_b_b[l],
                                    dt_bias[l], a_log[l], d_skip[l], norm_b_w[l], w_out[l])
        new_a.append(na)
        new_b.append(nb)
        new_s.append(ns)
    return rmsnorm(x, norm_f_w), jnp.stack(new_a), jnp.stack(new_b), jnp.stack(new_s)


def setup_inputs(seed: int = 0) -> dict:
    key = jax.random.key(seed)
    ks = jax.random.split(key, 24)
    f32 = jnp.float32
    nrm = lambda k, s, sc: jax.random.normal(k, s, f32) * sc
    dt0 = jnp.exp(jax.random.uniform(ks[15], (DEPTH, SSM_HEADS), f32) * (math.log(0.1) - math.log(0.001)) + math.log(0.001))
    return {
        "x_prompt": nrm(ks[0], (BATCH, SEQ, D_MODEL), 1.0),
        "x_sample": nrm(ks[1], (DEC_BATCH, DEC_SEQ, D_MODEL), 1.0),
        "state_conv_a": nrm(ks[2], (DEPTH, DEC_BATCH, CONV_A_W - 1, D_A), 0.5),
        "state_conv_b": nrm(ks[3], (DEPTH, DEC_BATCH, CONV_B_W - 1, D_XBC), 0.5),
        "state_ssm": nrm(ks[4], (DEPTH, DEC_BATCH, SSM_HEADS, SSM_HEADDIM, D_STATE), 0.1),
        "c_prompt": nrm(ks[5], (BATCH, D_MODEL), 1.0),
        "c_sample": nrm(ks[6], (DEC_BATCH, D_MODEL), 1.0),
        "w_mod": nrm(ks[7], (DEPTH, D_MODEL, 3 * D_MODEL), 0.5 * D_MODEL ** -0.5),
        "b_mod": nrm(ks[8], (DEPTH, 3 * D_MODEL), 0.02),
        "norm_in_w": 1.0 + nrm(ks[9], (DEPTH, D_MODEL), 0.02),
        "w_in": nrm(ks[10], (DEPTH, D_MODEL, D_IN_PROJ), D_MODEL ** -0.5),
        "conv_a_w": nrm(ks[11], (DEPTH, CONV_A_W, D_A), CONV_A_W ** -0.5),
        "norm_a_w": 1.0 + nrm(ks[12], (DEPTH, D_A), 0.02),
        "conv_b_w": nrm(ks[13], (DEPTH, CONV_B_W, D_XBC), CONV_B_W ** -0.5),
        "conv_b_b": nrm(ks[14], (DEPTH, D_XBC), 0.02),
        "dt_bias": dt0 + jnp.log(-jnp.expm1(-dt0)),
        "a_log": jnp.log(jax.random.uniform(ks[16], (DEPTH, SSM_HEADS), f32, 1.0, 16.0)),
        "d_skip": 1.0 + nrm(ks[17], (DEPTH, SSM_HEADS), 0.02),
        "norm_b_w": 1.0 + nrm(ks[18], (DEPTH, D_B), 0.02),
        "w_out": nrm(ks[19], (DEPTH, D_MIX, D_MODEL), D_MIX ** -0.5),
        "norm_f_w": 1.0 + nrm(ks[20], (D_MODEL,), 0.02),
    }


def reference(x_prompt, x_sample, state_conv_a, state_conv_b, state_ssm, c_prompt, c_sample,
              w_mod, b_mod, norm_in_w, w_in, conv_a_w, norm_a_w, conv_b_w, conv_b_b,
              dt_bias, a_log, d_skip, norm_b_w, w_out, norm_f_w):
    dt_ = x_prompt.dtype
    za = jnp.zeros((DEPTH, x_prompt.shape[0], CONV_A_W - 1, D_A), dt_)
    zb = jnp.zeros((DEPTH, x_prompt.shape[0], CONV_B_W - 1, D_XBC), dt_)
    zs = jnp.zeros((DEPTH, x_prompt.shape[0], SSM_HEADS, SSM_HEADDIM, D_STATE), state_ssm.dtype)
    y_prompt, conv_a_p, conv_b_p, ssm_p = trunk(
        x_prompt, c_prompt, za, zb, zs, w_mod, b_mod, norm_in_w, w_in, conv_a_w, norm_a_w,
        conv_b_w, conv_b_b, dt_bias, a_log, d_skip, norm_b_w, w_out, norm_f_w)
    y_sample, conv_a_s, conv_b_s, ssm_s = trunk(
        x_sample, c_sample, state_conv_a, state_conv_b, state_ssm, w_mod, b_mod, norm_in_w,
        w_in, conv_a_w, norm_a_w, conv_b_w, conv_b_b, dt_bias, a_log, d_skip, norm_b_w,
        w_out, norm_f_w)
    return (y_prompt, y_sample, conv_a_p, conv_b_p, ssm_p, conv_a_s, conv_b_s, ssm_s)
```

```cpp
#include <hip/hip_runtime.h>
#include <hip/hip_cooperative_groups.h>
#include <cstdio>
#include <cstdint>
namespace cg = cooperative_groups;


#define LAS __attribute__((address_space(3)))
typedef unsigned short bf16;
typedef short bf16x8 __attribute__((ext_vector_type(8)));
typedef float f32x4 __attribute__((ext_vector_type(4)));
typedef float f32x2 __attribute__((ext_vector_type(2)));
typedef unsigned u32x4 __attribute__((ext_vector_type(4)));
typedef unsigned u32x2 __attribute__((ext_vector_type(2)));

constexpr int D = 1024, MP = 32768, MS = 1024, MT = MP + MS;
constexpr int NSEQ = 18, NCHUNK = MT / 64;
constexpr int NIN = 7184, NINP = 7424;
constexpr int DXBC = 2048, LDACT = 3072;
constexpr float EPS = 1e-5f;
constexpr int NTHREADS = 512;
constexpr int LDS_BYTES = 147456;

constexpr size_t MiB = 1u << 20;
constexpr size_t WS_MOD = 0;
constexpr size_t WS_WTIN = 1 * MiB;
constexpr size_t WS_WTOUT = 16 * MiB;
constexpr size_t WS_SS = 20 * MiB;
constexpr size_t WS_SSF = 22 * MiB;
constexpr size_t WS_CD = 25 * MiB;
constexpr size_t WS_DTR = 26 * MiB;
constexpr size_t WS_DTV = 29 * MiB;
constexpr size_t WS_ACU = 32 * MiB;
constexpr size_t WS_BAR = 35 * MiB;
constexpr size_t WS_ACT = 36 * MiB;
constexpr size_t WS_XBC = 234 * MiB;
constexpr size_t WS_ST = 366 * MiB;
constexpr size_t WS_OUTS = WS_XBC;
constexpr size_t WS_DELTA = WS_XBC + 32 * MiB;
constexpr size_t WS_END = 498 * MiB;
constexpr int XSI_UNIT = 256 * 72, BNI_UNIT = 64 * 136;
constexpr size_t BNI_OFF = 80 * MiB;
constexpr int NRUN = 256;
constexpr size_t RA_OFF = 116 * MiB;
constexpr size_t WS_RD = 25 * MiB + 64 * 1024;
constexpr size_t WS_CDP = 25 * MiB + 128 * 1024;

__device__ __forceinline__ unsigned cvt_pk_bf16(float lo, float hi) { unsigned r; asm volatile("v_cvt_pk_bf16_f32 %0, %1, %2" : "=v"(r) : "v"(lo), "v"(hi)); return r; }
__device__ __forceinline__ float bf2f(unsigned b) { return __uint_as_float(b << 16); }
__device__ __forceinline__ float bflo(unsigned w) { return __uint_as_float(w << 16); }
__device__ __forceinline__ float bfhi(unsigned w) { return __uint_as_float(w & 0xffff0000u); }
__device__ __forceinline__ float silu_f(float v) { return v * __builtin_amdgcn_rcpf(1.f + __expf(-v)); }
__device__ __forceinline__ float wave_sum(float v) {
#pragma unroll
    for (int o = 1; o < 64; o <<= 1) v += __shfl_xor(v, o);
    return v;
}
__device__ __forceinline__ int seq_of_row(int row) { return row < MP ? (row >> 14) : 2 + ((row - MP) >> 6); }

namespace pg8 {
constexpr int BM = 256, BK = 64, HALF = 128, HTB = HALF * BK * 2, STAGE_BYTES = 8 * HTB, NXCD = 8, WGM = 8;
__host__ __device__ __forceinline__ int lds_byte(int r, int c) { const int st = (r >> 4) * 2 + (c >> 5), rr = r & 15, cc = c & 31, ob = rr * 64 + cc * 2; return st * 1024 + (ob ^ (((ob >> 9) & 1) << 5)); }
__host__ __device__ __forceinline__ void stage_rc(int b, int& R, int& C) { const int st = b / 1024, sb = b % 1024, swz = sb ^ (((sb >> 9) & 1) << 5); R = (st >> 1) * 16 + swz / 64; C = (st & 1) * 32 + (swz % 64) / 2; }
__host__ __device__ __forceinline__ int perm32(int rho) { const int n = rho >> 4, i = rho & 15; return 8 * (i >> 2) + 4 * n + (i & 3); }
struct Unit { int pm, pn, k0, nt; };
struct Gemm { const bf16* A; const bf16* Bt; int M, N, K, lda; };
struct StaticOrder {
    int nM, nN, nwg, G, c, ntf;
    __device__ void init(int M, int N, int K, int G_, int c_) { nM = M / BM; nN = N / BM; nwg = nM * nN; G = G_; c = c_; ntf = K / BK; }
    __device__ bool next(int i, Unit& u) const {
        const long L = (long)i * G + c; if (L >= nwg) return false;
        u.k0 = 0; u.nt = ntf;
        int wgid = (int)L; { const int q = nwg / NXCD, r = nwg % NXCD, xcd = wgid % NXCD, off = wgid / NXCD; wgid = (xcd < r ? xcd * (q + 1) : r * (q + 1) + (xcd - r) * q) + off; }
        const int nig = WGM * nN, gid = wgid / nig, fm = gid * WGM, gsz = (nM - fm) < WGM ? (nM - fm) : WGM;
        u.pm = fm + ((wgid % nig) % gsz); u.pn = (wgid % nig) / gsz; return true;
    }
};

struct SplitOrder {
    StaticOrder main; int nmain, G, c;
    __device__ void init(int G_, int c_) { main.init(MP, D, 2048, G_, c_); nmain = main.nwg; G = G_; c = c_; }
    __device__ bool next(int i, Unit& u) const {
        const long L = (long)i * G + c;
        if (L < nmain) return main.next(i, u);
        const int r = (int)(L - nmain); if (r >= 128) return false;
        u.pm = MP / BM + (r >> 5); u.pn = (r & 31) >> 3; u.k0 = (r & 7) * 256; u.nt = 4; return true;
    }
};

template <class Epi, class Order>
__device__ __forceinline__ void gemm_phase(LAS unsigned char* lds, const Gemm g, const Order& S, const Epi& E) {
    int tid = threadIdx.x; asm volatile("" : "+v"(tid));
    const int wid = __builtin_amdgcn_readfirstlane(tid >> 6), lane = tid & 63, wr = wid >> 2, wc = wid & 3, fr = lane & 15, fq = lane >> 4;
    const int K = g.K, lda = g.lda;
    unsigned voffA[2], voffB[2];
#pragma unroll
    for (int i = 0; i < 2; ++i) { int R, C; stage_rc(tid * 16 + i * 8192, R, C); const int Rb = Epi::PERM ? ((R & ~31) + perm32(R & 31)) : R;
        voffA[i] = (unsigned)(R * lda + C) * 2u; voffB[i] = (unsigned)(Rb * K + C) * 2u; }
    const size_t kstep = (size_t)(BK * 2);
    const size_t hstepA = (size_t)HALF * lda * 2, tstepA = 2 * hstepA;
    const size_t hstepB = (size_t)HALF * K * 2, tstepB = 2 * hstepB;
    const unsigned ldsw = (unsigned)wid * 1024u;
    const int aoff = lds_byte(wr * 64 + fr, fq * 8), boff = lds_byte(wc * 32 + fr, fq * 8);
#define PG8_SA(b, h) (((b) * 2 + (h)) * HTB)
#define PG8_SB(b, h) ((4 + (b) * 2 + (h)) * HTB)
#define PG8_STAGE(bufoff, gbase, voff) do { _Pragma("unroll") for (int _i = 0; _i < 2; ++_i) \
        __builtin_amdgcn_global_load_lds((const unsigned*)((const char*)(gbase) + (voff)[_i]), (LAS unsigned*)(lds + (bufoff) + ldsw + _i * 8192), 16, 0, 0); } while (0)
#define PG8_LDA(dst, b, h) do { _Pragma("unroll") for (int m = 0; m < 4; ++m) _Pragma("unroll") for (int k = 0; k < 2; ++k) dst[m][k] = *(const LAS bf16x8*)(lds + PG8_SA(b, h) + aoff + m * 2048 + k * 1024); } while (0)
#define PG8_LDB(dst, b, h) do { _Pragma("unroll") for (int n = 0; n < 2; ++n) _Pragma("unroll") for (int k = 0; k < 2; ++k) dst[n][k] = *(const LAS bf16x8*)(lds + PG8_SB(b, h) + boff + n * 2048 + k * 1024); } while (0)
#define PG8_MMA(ai, bj, At, Bt) do { __builtin_amdgcn_s_setprio(1); _Pragma("unroll") for (int m = 0; m < 4; ++m) _Pragma("unroll") for (int n = 0; n < 2; ++n) _Pragma("unroll") for (int k = 0; k < 2; ++k) \
        acc[ai][bj][m][n] = __builtin_amdgcn_mfma_f32_16x16x32_bf16(Bt[n][k], At[m][k], acc[ai][bj][m][n], 0, 0, 0); __builtin_amdgcn_s_setprio(0); } while (0)
#define PG8_WAIT_V(n) asm volatile("s_waitcnt vmcnt(" #n ")" ::: "memory")
#define PG8_WAIT_L(n) asm volatile("s_waitcnt lgkmcnt(" #n ")" ::: "memory")
#define PG8_BAR __builtin_amdgcn_s_barrier()
#define PG8_SCHED __builtin_amdgcn_sched_barrier(0)
    Unit cur, nxt; int ui = 0;
    if (!S.next(0, cur)) return;
    f32x4 acc[2][2][4][2];
#pragma unroll
    for (int a = 0; a < 2; ++a)
#pragma unroll
        for (int b = 0; b < 2; ++b)
#pragma unroll
            for (int m = 0; m < 4; ++m)
#pragma unroll
                for (int n = 0; n < 2; ++n) acc[a][b][m][n] = (f32x4){0.f, 0.f, 0.f, 0.f};
    bf16x8 At[4][2], B0[2][2], B1[2][2];
    const char* cA = (const char*)g.A + (size_t)cur.pm * tstepA + (size_t)cur.k0 * 2; const char* cB = (const char*)g.Bt + (size_t)cur.pn * tstepB + (size_t)cur.k0 * 2;
    PG8_STAGE(PG8_SB(0, 0), cB, voffB); PG8_STAGE(PG8_SA(0, 0), cA, voffA); PG8_STAGE(PG8_SB(0, 1), cB + hstepB, voffB); PG8_STAGE(PG8_SA(0, 1), cA + hstepA, voffA);
    if (wr == 1) PG8_BAR;
    PG8_WAIT_V(4); PG8_BAR;
    PG8_STAGE(PG8_SB(1, 0), cB + kstep, voffB); PG8_STAGE(PG8_SA(1, 0), cA + kstep, voffA); PG8_STAGE(PG8_SB(1, 1), cB + hstepB + kstep, voffB);
    PG8_WAIT_V(6); PG8_BAR;
    for (;;) {
        const bool has_next = S.next(ui + 1, nxt);
        const char* nA = has_next ? (const char*)g.A + (size_t)nxt.pm * tstepA + (size_t)nxt.k0 * 2 : cA; const char* nB = has_next ? (const char*)g.Bt + (size_t)nxt.pn * tstepB + (size_t)nxt.k0 * 2 : cB;
        const int nt = cur.nt;
        for (int t = 0; t < nt; t += 2) {
            const bool last = (t == nt - 2);
            const char* a1 = cA + (size_t)(t + 1) * kstep;
            const char* a2 = last ? nA : cA + (size_t)(t + 2) * kstep; const char* b2 = last ? nB : cB + (size_t)(t + 2) * kstep;
            const char* a3 = a2 + kstep; const char* b3 = b2 + kstep;
            if constexpr (Epi::HAS_MID) { if (t == 16 && nt == 32) E.mid(acc, cur, wr, fr); }
            PG8_LDB(B0, 0, 0); PG8_SCHED; PG8_LDA(At, 0, 0); PG8_STAGE(PG8_SA(1, 1), a1 + hstepA, voffA);
            PG8_WAIT_L(8); PG8_BAR; PG8_WAIT_L(0); PG8_MMA(0, 0, At, B0); PG8_BAR; PG8_SCHED;
            PG8_LDB(B1, 0, 1); PG8_STAGE(PG8_SB(0, 0), b2, voffB);
            PG8_BAR; PG8_WAIT_L(0); PG8_MMA(0, 1, At, B1); PG8_BAR;
            PG8_LDA(At, 0, 1); PG8_STAGE(PG8_SA(0, 0), a2, voffA);
            PG8_BAR; PG8_WAIT_L(0); PG8_MMA(1, 0, At, B0); PG8_BAR; PG8_SCHED;
            PG8_STAGE(PG8_SB(0, 1), b2 + hstepB, voffB);
            PG8_WAIT_V(6); PG8_BAR; PG8_MMA(1, 1, At, B1); PG8_BAR;
            PG8_LDB(B0, 1, 0); PG8_SCHED; PG8_LDA(At, 1, 0); PG8_STAGE(PG8_SA(0, 1), a2 + hstepA, voffA);
            PG8_WAIT_L(8); PG8_BAR; PG8_WAIT_L(0); PG8_MMA(0, 0, At, B0); PG8_BAR; PG8_SCHED;
            PG8_LDB(B1, 1, 1); PG8_STAGE(PG8_SB(1, 0), b3, voffB);
            PG8_BAR; PG8_WAIT_L(0); PG8_MMA(0, 1, At, B1); PG8_BAR;
            PG8_LDA(At, 1, 1); PG8_STAGE(PG8_SA(1, 0), a3, voffA);
            PG8_BAR; PG8_WAIT_L(0); PG8_MMA(1, 0, At, B0); PG8_BAR; PG8_SCHED;
            PG8_STAGE(PG8_SB(1, 1), b3 + hstepB, voffB);
            PG8_WAIT_V(6); PG8_BAR; PG8_MMA(1, 1, At, B1); PG8_BAR;
        }
        E(acc, cur, wr, wc, fr, fq);
        if (!has_next) break;
#pragma unroll
        for (int a = 0; a < 2; ++a)
#pragma unroll
            for (int b = 0; b < 2; ++b)
#pragma unroll
                for (int m = 0; m < 4; ++m)
#pragma unroll
                    for (int n = 0; n < 2; ++n) acc[a][b][m][n] = (f32x4){0.f, 0.f, 0.f, 0.f};
        cur = nxt; cA = nA; cB = nB; ++ui;
    }
    PG8_WAIT_V(0);
    if (wr == 0) PG8_BAR;
    PG8_BAR;
#undef PG8_SA
#undef PG8_SB
#undef PG8_STAGE
#undef PG8_LDA
#undef PG8_LDB
#undef PG8_MMA
#undef PG8_WAIT_V
#undef PG8_WAIT_L
#undef PG8_BAR
#undef PG8_SCHED
}

struct EpiIn {
    static constexpr bool PERM = true, HAS_MID = false;
    bf16* ACT; bf16* XBC; float* DTR;
    __device__ __forceinline__ void operator()(const f32x4 (&acc)[2][2][4][2], const Unit& u, int wr, int wc, int fr, int fq) const {
        const int row0 = u.pm * BM + wr * 64 + fr;
        if (u.pn < 16) {
            bf16* base = ACT + (wc < 2 ? 0 : 1024) + 64 * u.pn + 32 * (wc & 1) + 8 * fq;
#pragma unroll
            for (int ai = 0; ai < 2; ++ai)
#pragma unroll
                for (int m = 0; m < 4; ++m) {
                    const f32x4 a0 = acc[ai][0][m][0], a1 = acc[ai][0][m][1], b0 = acc[ai][1][m][0], b1 = acc[ai][1][m][1];
                    f32x4 v0, v1;
                    if (wc < 2) { v0 = a0 * b0; v1 = a1 * b1; }
                    else {
#pragma unroll
                        for (int j = 0; j < 4; ++j) { v0[j] = a0[j] * silu_f(b0[j]); v1[j] = a1[j] * silu_f(b1[j]); }
                    }
                    u32x4 w; w.x = cvt_pk_bf16(v0[0], v0[1]); w.y = cvt_pk_bf16(v0[2], v0[3]); w.z = cvt_pk_bf16(v1[0], v1[1]); w.w = cvt_pk_bf16(v1[2], v1[3]);
                    *(u32x4*)(base + (size_t)(row0 + ai * HALF + m * 16) * LDACT) = w;
                }
        } else if (u.pn < 28) {
            bf16* base; int ld;
            if (u.pn < 20) { base = ACT + 2048 + (u.pn - 16) * 256 + 32 * wc + 8 * fq; ld = LDACT; }
            else { base = XBC + (u.pn - 20) * 256 + 32 * wc + 8 * fq; ld = DXBC; }
#pragma unroll
            for (int ai = 0; ai < 2; ++ai)
#pragma unroll
                for (int m = 0; m < 4; ++m) {
                    bf16* rowp = base + (size_t)(row0 + ai * HALF + m * 16) * ld;
#pragma unroll
                    for (int bj = 0; bj < 2; ++bj) {
                        const f32x4 v0 = acc[ai][bj][m][0], v1 = acc[ai][bj][m][1];
                        u32x4 w; w.x = cvt_pk_bf16(v0[0], v0[1]); w.y = cvt_pk_bf16(v0[2], v0[3]); w.z = cvt_pk_bf16(v1[0], v1[1]); w.w = cvt_pk_bf16(v1[2], v1[3]);
                        *(u32x4*)(rowp + bj * HALF) = w;
                    }
                }
        } else {
            if (wc == 0 && fq < 2) {
#pragma unroll
                for (int ai = 0; ai < 2; ++ai)
#pragma unroll
                    for (int m = 0; m < 4; ++m) {
                        float* p = DTR + (size_t)(row0 + ai * HALF + m * 16) * 16 + 8 * fq;
                        *(f32x4*)p = acc[ai][0][m][0]; *(f32x4*)(p + 4) = acc[ai][0][m][1];
                    }
            }
        }
    }
};

struct EpiOut {
    static constexpr bool PERM = true, HAS_MID = true;
    const float* MOD; const float* SS; bf16* DELTA; float* OUTS;
    __device__ __forceinline__ void mid(f32x4 (&acc)[2][2][4][2], const Unit& u, int wr, int fr) const {
        int rbase = u.pm * BM + wr * 64 + fr;
        asm volatile("" : "+v"(rbase));
#pragma unroll
        for (int ai = 0; ai < 2; ++ai)
#pragma unroll
            for (int m = 0; m < 4; ++m) {
                const int row = rbase + ai * HALF + m * 16;
                const f32x4 sa = *(const f32x4*)(SS + (size_t)row * 8), sb = *(const f32x4*)(SS + (size_t)row * 8 + 4);
                const float va = (sa[0] + sa[1]) + (sa[2] + sa[3]), vb = (sb[0] + sb[1]) + (sb[2] + sb[3]);
                const float tb = vb * (1.f / 1024.f) + EPS;
                const float ratio = rsqrtf(va * (1.f / 1024.f) + EPS) * (tb * rsqrtf(tb));
#pragma unroll
                for (int bj = 0; bj < 2; ++bj)
#pragma unroll
                    for (int n = 0; n < 2; ++n) acc[ai][bj][m][n] *= ratio;
                __builtin_amdgcn_sched_barrier(0);
            }
    }
    __device__ __forceinline__ void operator()(const f32x4 (&acc)[2][2][4][2], const Unit& u, int wr, int wc, int fr, int fq) const {
        const int col0 = u.pn * BM + wc * 32 + 8 * fq;
        if (u.nt != 32) {
#pragma unroll
            for (int ai = 0; ai < 2; ++ai)
#pragma unroll
                for (int m = 0; m < 4; ++m) {
                    const int row = u.pm * BM + ai * HALF + wr * 64 + m * 16 + fr;
                    const f32x4 sv = *(const f32x4*)(SS + (size_t)row * 8 + (u.k0 < 1024 ? 0 : 4));
                    const float rs = rsqrtf(((sv[0] + sv[1]) + (sv[2] + sv[3])) * (1.f / 1024.f) + EPS);
                    float* op = OUTS + ((size_t)(u.k0 >> 8) * MS + (row - MP)) * D + col0;
#pragma unroll
                    for (int bj = 0; bj < 2; ++bj)
#pragma unroll
                        for (int n = 0; n < 2; ++n) *(f32x4*)(op + bj * HALF + n * 4) = acc[ai][bj][m][n] * rs;
                }
            return;
        }
        const float* gp = MOD + (u.pm >> 6) * 3072 + 2048 + col0;
        f32x4 gv[2][2];
#pragma unroll
        for (int bj = 0; bj < 2; ++bj)
#pragma unroll
            for (int n = 0; n < 2; ++n) gv[bj][n] = *(const f32x4*)(gp + bj * HALF + n * 4);
#pragma unroll
        for (int ai = 0; ai < 2; ++ai)
#pragma unroll
            for (int m = 0; m < 4; ++m) {
                const int row = u.pm * BM + ai * HALF + wr * 64 + m * 16 + fr;
                const f32x4 sb = *(const f32x4*)(SS + (size_t)row * 8 + 4);
                const float rb = rsqrtf(((sb[0] + sb[1]) + (sb[2] + sb[3])) * (1.f / 1024.f) + EPS);
                bf16* op = DELTA + (size_t)row * D + col0;
#pragma unroll
                for (int bj = 0; bj < 2; ++bj) {
                    const f32x4 v0 = gv[bj][0] * (acc[ai][bj][m][0] * rb), v1 = gv[bj][1] * (acc[ai][bj][m][1] * rb);
                    u32x4 w; w.x = cvt_pk_bf16(v0[0], v0[1]); w.y = cvt_pk_bf16(v0[2], v0[3]); w.z = cvt_pk_bf16(v1[0], v1[1]); w.w = cvt_pk_bf16(v1[2], v1[3]);
                    *(u32x4*)(op + bj * HALF) = w;
                }
            }
    }
};
}

struct Args {
    const float* in[21]; float* out; unsigned char* ws; int pad0, pad1;
};
enum { I_XP = 0, I_XS, I_SCA, I_SCB, I_SSM, I_CP, I_CS, I_WMOD, I_BMOD, I_NIN, I_WIN, I_CAW, I_NAW, I_CBW, I_CBB, I_DTB, I_ALOG, I_DSKIP, I_NBW, I_WOUT, I_NFW };
constexpr size_t O_Y = 0, O_CAP = 34603008, O_CBP = 34607104, O_SSMP = 34619392, O_CAS = 34881536, O_CBS = 34914304, O_SSMS = 35012608, O_END = 37109760;

__device__ __forceinline__ int in_srccol(int n) {
    if (n < 4096) { const int w = n & 255, seg = w >> 6, j = (n >> 8) * 64 + (w & 63); const int off = seg == 0 ? 1024 : (seg == 1 ? 0 : (seg == 2 ? 2048 : 3072)); return off + j; }
    return n < NIN ? n : -1;
}
template <bool IN>
__device__ __forceinline__ void p0_transpose_item(const float* W, int K, int Nsrc, bf16* WT, LAS float* scr, int k0, int n0, int lane) {
    const int nd = n0 + (lane & 31); const int src = IN ? in_srccol(nd) : nd;
#pragma unroll
    for (int i = 0; i < 32; ++i) { const int kk = 2 * i + (lane >> 5); scr[kk * 33 + (lane & 31)] = src >= 0 ? W[(size_t)(k0 + kk) * Nsrc + src] : 0.f; }
    asm volatile("s_waitcnt lgkmcnt(0)" ::: "memory");
    const int c = lane & 7;
#pragma unroll
    for (int j = 0; j < 4; ++j) { const int n = (lane >> 3) + 8 * j; const LAS float* s = scr + (8 * c) * 33 + n;
        u32x4 o; o.x = cvt_pk_bf16(s[0 * 33], s[1 * 33]); o.y = cvt_pk_bf16(s[2 * 33], s[3 * 33]); o.z = cvt_pk_bf16(s[4 * 33], s[5 * 33]); o.w = cvt_pk_bf16(s[6 * 33], s[7 * 33]);
        *(u32x4*)(WT + (size_t)(n0 + n) * K + k0 + 8 * c) = o; }
    asm volatile("s_waitcnt lgkmcnt(0)" ::: "memory");
}

__device__ __forceinline__ void p0_prologue(const Args& a, LAS unsigned char* lds, int bid, int G) {
    int tid = threadIdx.x; asm volatile("" : "+v"(tid));

    for (int item = bid; item < 192; item += G) {
        LAS float* cl = (LAS float*)lds;
        LAS float* red = (LAS float*)(lds + 73728);
        for (int i = tid; i < NSEQ * 1024 / 4; i += NTHREADS) ((LAS f32x4*)cl)[i] = i < 512 ? ((const f32x4*)a.in[I_CP])[i] : ((const f32x4*)a.in[I_CS])[i - 512];
        const int col = tid & 15, kg = tid >> 4, j0 = item * 16;
        const float* wm = a.in[I_WMOD] + (size_t)(kg * 32) * 3072 + j0 + col;
        float w[32];
#pragma unroll
        for (int kk = 0; kk < 32; ++kk) w[kk] = wm[(size_t)kk * 3072];
        __syncthreads();
        float acc[NSEQ];
#pragma unroll
        for (int s = 0; s < NSEQ; ++s) acc[s] = 0.f;
#pragma unroll
        for (int k4 = 0; k4 < 8; ++k4) {
#pragma unroll
            for (int s = 0; s < NSEQ; ++s) { const f32x4 c4 = *(const LAS f32x4*)(cl + s * 1024 + kg * 32 + 4 * k4);
                acc[s] += (c4[0] * w[4 * k4] + c4[1] * w[4 * k4 + 1]) + (c4[2] * w[4 * k4 + 2] + c4[3] * w[4 * k4 + 3]); }
        }
#pragma unroll
        for (int s = 0; s < NSEQ; ++s) red[(kg * NSEQ + s) * 16 + col] = acc[s];
        __syncthreads();
        for (int o = tid; o < NSEQ * 16; o += NTHREADS) { const int s = o >> 4, c = o & 15; float v = a.in[I_BMOD][j0 + c];
#pragma unroll
            for (int k2 = 0; k2 < 32; ++k2) v += red[(k2 * NSEQ + s) * 16 + c];
            ((float*)(a.ws + WS_MOD))[s * 3072 + j0 + c] = v; }
        __syncthreads();
    }
}
__device__ __forceinline__ void p1_transposes(const Args& a, LAS unsigned char* lds, int bid, int G) {
    int tid = threadIdx.x; asm volatile("" : "+v"(tid));
    const int lane = tid & 63, wave = tid >> 6;
    LAS float* scr = (LAS float*)(lds + wave * 16384);
    const int gw = bid * 8 + wave, NGW = G * 8;
    constexpr int I_IN = (NINP / 32) * (D / 64), I_OUT = (D / 32) * (2048 / 64);
    for (int it = gw; it < I_IN + I_OUT; it += NGW) {
        if (it < I_IN) { const int nb = it / (D / 64), kb = it % (D / 64); p0_transpose_item<true>(a.in[I_WIN], D, NIN, (bf16*)(a.ws + WS_WTIN), scr, kb * 64, nb * 32, lane); }
        else { const int r = it - I_IN; const int nb = r / 32, kb = r % 32; p0_transpose_item<false>(a.in[I_WOUT], 2048, D, (bf16*)(a.ws + WS_WTOUT), scr, kb * 64, nb * 32, lane); }
    }
}

__device__ __forceinline__ void p1_norm(const Args& a, int bid, int G) {
    int tid = threadIdx.x; asm volatile("" : "+v"(tid));
    const int lane = tid & 63, wave = tid >> 6;
    const float* MOD = (const float*)(a.ws + WS_MOD); bf16* H = (bf16*)a.out;
    f32x4 nw[4];
#pragma unroll
    for (int j = 0; j < 4; ++j) nw[j] = ((const f32x4*)a.in[I_NIN])[lane + 64 * j];
    for (int row = bid * 8 + wave; row < MT; row += G * 8) {
        const f32x4* xr = (const f32x4*)(row < MP ? a.in[I_XP] + (size_t)row * D : a.in[I_XS] + (size_t)(row - MP) * D);
        const int s = seq_of_row(row);
        f32x4 v[4]; float ss = 0.f;
#pragma unroll
        for (int j = 0; j < 4; ++j) { v[j] = xr[lane + 64 * j]; ss += (v[j][0] * v[j][0] + v[j][1] * v[j][1]) + (v[j][2] * v[j][2] + v[j][3] * v[j][3]); }
        const float rstd = rsqrtf(wave_sum(ss) * (1.f / D) + EPS);
        const f32x4* sh = (const f32x4*)(MOD + s * 3072); const f32x4* sc = (const f32x4*)(MOD + s * 3072 + 1024);
        u32x2* o = (u32x2*)(H + (size_t)row * D);
#pragma unroll
        for (int j = 0; j < 4; ++j) { const f32x4 h = v[j] * rstd * nw[j] * (sc[lane + 64 * j] + 1.f) + sh[lane + 64 * j];
            u32x2 w; w.x = cvt_pk_bf16(h[0], h[1]); w.y = cvt_pk_bf16(h[2], h[3]); o[lane + 64 * j] = w; }
    }
}

__device__ __forceinline__ u32x4 pack8(const float (&v)[8]) { u32x4 w; w.x = cvt_pk_bf16(v[0], v[1]); w.y = cvt_pk_bf16(v[2], v[3]); w.z = cvt_pk_bf16(v[4], v[5]); w.w = cvt_pk_bf16(v[6], v[7]); return w; }
__device__ __forceinline__ float rawel(const u32x4& w, int c) { const unsigned x = w[c >> 1]; return (c & 1) ? bfhi(x) : bflo(x); }
__device__ __forceinline__ void conv_load(const bf16* XBC, const float* stb, int cidx, int xcol, int rs, u32x4 (&r)[11]) {
    const bf16* p = XBC + (size_t)(cidx * 64 + 8 * rs - 3) * DXBC + xcol;
#pragma unroll
    for (int k = 3; k < 11; ++k) r[k] = *(const u32x4*)(p + (size_t)k * DXBC);
    if (rs > 0 || (cidx < 512 && (cidx & 255) != 0)) {
#pragma unroll
        for (int k = 0; k < 3; ++k) r[k] = *(const u32x4*)(p + (size_t)k * DXBC);
    } else if (cidx >= 512) {
        const float* s = stb + (size_t)(cidx - 512) * 3 * DXBC + xcol;
#pragma unroll
        for (int k = 0; k < 3; ++k) { const f32x4 a0 = *(const f32x4*)(s + k * DXBC), a1 = *(const f32x4*)(s + k * DXBC + 4);
            r[k].x = cvt_pk_bf16(a0[0], a0[1]); r[k].y = cvt_pk_bf16(a0[2], a0[3]); r[k].z = cvt_pk_bf16(a1[0], a1[1]); r[k].w = cvt_pk_bf16(a1[2], a1[3]); }
    } else {
#pragma unroll
        for (int k = 0; k < 3; ++k) r[k] = (u32x4){0u, 0u, 0u, 0u};
    }
}
struct ConvW { f32x4 w[4][2]; f32x4 b[2]; };
__device__ __forceinline__ void convw_load(const float* cw, const float* cb, int xcol, ConvW& W) {
#pragma unroll
    for (int j = 0; j < 4; ++j) { W.w[j][0] = *(const f32x4*)(cw + j * DXBC + xcol); W.w[j][1] = *(const f32x4*)(cw + j * DXBC + xcol + 4); }
    W.b[0] = *(const f32x4*)(cb + xcol); W.b[1] = *(const f32x4*)(cb + xcol + 4);
}
__device__ __forceinline__ float conv_el(const u32x4 (&r)[11], const ConvW& W, int t, int c) {
    const float v = W.b[c >> 2][c & 3] + W.w[0][c >> 2][c & 3] * rawel(r[t], c) + W.w[1][c >> 2][c & 3] * rawel(r[t + 1], c) + W.w[2][c >> 2][c & 3] * rawel(r[t + 2], c) + W.w[3][c >> 2][c & 3] * rawel(r[t + 3], c);
    return silu_f(v);
}
__device__ __forceinline__ float softplus_f(float x) { return x > 20.f ? x : log1pf(__expf(x)); }

#define WG_BAR() do { asm volatile("s_waitcnt lgkmcnt(0)" ::: "memory"); __builtin_amdgcn_s_barrier(); asm volatile("" ::: "memory"); } while (0)
__device__ __forceinline__ void p3_states(const Args& a, LAS unsigned char* lds, int bid, int G) {
    int tid = threadIdx.x; asm volatile("" : "+v"(tid));
    const int lane = tid & 63, wave = __builtin_amdgcn_readfirstlane(tid >> 6), fr = lane & 15, fq = lane >> 4;
    const bf16* XBC = (const bf16*)(a.ws + WS_XBC); const float* DTR = (const float*)(a.ws + WS_DTR);
    float* DTV = (float*)(a.ws + WS_DTV); float* ACU = (float*)(a.ws + WS_ACU); float* CD = (float*)(a.ws + WS_CD);
    bf16* ST = (bf16*)(a.ws + WS_ST);
    LAS float* dtw2 = (LAS float*)lds; LAS float* cdl2 = (LAS float*)(lds + 2048);
    LAS bf16* xsT = (LAS bf16*)(lds + 4096); LAS bf16* BT = (LAS bf16*)(lds + 40960);
    bf16* XSI = (bf16*)a.out; bf16* BNI = (bf16*)((unsigned char*)a.out + BNI_OFF);
    const int rs = lane & 7, cg = 8 * wave + (lane >> 3);
    bf16* RA = (bf16*)((unsigned char*)a.out + RA_OFF); float* RD = (float*)(a.ws + WS_RD); float* CDP = (float*)(a.ws + WS_CDP);
#define P3_DT(CIDX, GG, BUF, DTRAW) do { if (wave < 4) { const int cidx_ = (CIDX), h_ = 4 * (GG) + wave, row_ = cidx_ * 64 + lane; \
        const float dt = softplus_f((DTRAW) + a.in[I_DTB][h_]); const float da = dt * -__expf(a.in[I_ALOG][h_]); float ac = da; \
        _Pragma("unroll") for (int o = 1; o < 64; o <<= 1) { const float t = __shfl_up(ac, o); if (lane >= o) ac += t; } \
        const float tot = __shfl(ac, 63); \
        dtw2[(BUF) * 256 + lane * 4 + wave] = dt * __expf(tot - ac); \
        DTV[(size_t)row_ * 16 + h_] = dt; ACU[(size_t)row_ * 16 + h_] = ac; \
        if (lane == 63) { const float cdv = __expf(tot); CD[cidx_ * 16 + h_] = cdv; cdl2[(BUF) * 4 + wave] = cdv; } } } while (0)
    for (int rho = bid; rho < NRUN + 64; rho += G) {
      const bool samp = rho >= NRUN;
      const int g = samp ? ((rho - NRUN) & 3) : ((rho >> 5) & 3);
      const int cbase = samp ? 512 + ((rho - NRUN) >> 2) : (rho >> 7) * 256 + (rho & 31) * 8;
      const int nci = samp ? 1 : 8;
      f32x4 acc[4][4];
#pragma unroll
      for (int i = 0; i < 4; ++i)
#pragma unroll
          for (int j = 0; j < 4; ++j) acc[i][j] = (f32x4){0.f, 0.f, 0.f, 0.f};
      float cum = 1.f;
      LAS float* cwl = (LAS float*)(lds + 59392);
      for (int i = tid; i < 5 * 384; i += NTHREADS) { const int j = i / 384, col = i - j * 384; const int xc = col < 256 ? 256 * g + col : 1024 + 128 * g + (col - 256);
          cwl[i] = j < 4 ? a.in[I_CBW][j * DXBC + xc] : a.in[I_CBB][xc]; }
      { const float d0 = DTR[(size_t)(cbase * 64 + lane) * 16 + 4 * g + (wave & 3)]; P3_DT(cbase, g, 0, d0); }
      __syncthreads();
#pragma unroll 1
      for (int ci = 0; ci < nci; ++ci) {
        const int cidx = cbase + ci, unit = cidx * 4 + g, row0 = cidx * 64;
        u32x4 r[11];
        const int xcol = cg < 32 ? 256 * g + 8 * cg : 1024 + 128 * g + 8 * (cg - 32);
        if (wave < 6) conv_load(XBC, a.in[I_SCB], cidx, xcol, rs, r);
        const int pb = ci & 1;
        const float dnext = DTR[(size_t)((ci + 1 < nci ? cidx + 1 : cidx) * 64 + lane) * 16 + 4 * g + (wave & 3)];
        if (wave < 6 && rs == 7 && (cidx >= 512 || (cidx & 255) == 255)) {
            float* op = cidx >= 512 ? a.out + O_CBS + (size_t)(cidx - 512) * 3 * DXBC + xcol : a.out + O_CBP + (size_t)(cidx >> 8) * 3 * DXBC + xcol;
#pragma unroll
            for (int k = 0; k < 3; ++k) { *(f32x4*)(op + k * DXBC) = (f32x4){rawel(r[8 + k], 0), rawel(r[8 + k], 1), rawel(r[8 + k], 2), rawel(r[8 + k], 3)};
                *(f32x4*)(op + k * DXBC + 4) = (f32x4){rawel(r[8 + k], 4), rawel(r[8 + k], 5), rawel(r[8 + k], 6), rawel(r[8 + k], 7)}; }
        }
        if (wave < 4) {
            LAS bf16* dst = xsT + (8 * cg) * 72 + 8 * rs;
            bf16* gi = XSI + (size_t)unit * XSI_UNIT + (8 * cg) * 72 + 8 * rs;
            float sc[8];
#pragma unroll
            for (int t = 0; t < 8; ++t) sc[t] = dtw2[pb * 256 + (8 * rs + t) * 4 + wave];
#pragma unroll
            for (int c = 0; c < 8; ++c) {
                float o[8]; const LAS float* wp = cwl + 8 * cg + c;
                const float w0 = wp[0], w1 = wp[384], w2 = wp[768], w3 = wp[1152], wb = wp[1536];
#pragma unroll
                for (int t = 0; t < 8; ++t) o[t] = silu_f(wb + w0 * rawel(r[t], c) + w1 * rawel(r[t + 1], c) + w2 * rawel(r[t + 2], c) + w3 * rawel(r[t + 3], c));
                *(u32x4*)(gi + c * 72) = pack8(o);
#pragma unroll
                for (int t = 0; t < 8; ++t) o[t] *= sc[t];
                *(LAS u32x4*)(dst + c * 72) = pack8(o);
            }
        } else if (wave < 6) {
            LAS bf16* dst = BT + (8 * (cg - 32)) * 72 + 8 * rs;
            bf16* gi = BNI + (size_t)unit * BNI_UNIT + (8 * rs) * 136 + 8 * (cg - 32);
            u32x4 rowpk[8];
#pragma unroll
            for (int c2 = 0; c2 < 4; ++c2) {
                float o0[8], o1[8]; const LAS float* wp = cwl + 8 * cg + 2 * c2;
                const float w0 = wp[0], w1 = wp[384], w2 = wp[768], w3 = wp[1152], wb = wp[1536], v0 = wp[1], v1 = wp[385], v2 = wp[769], v3 = wp[1153], vb = wp[1537];
#pragma unroll
                for (int t = 0; t < 8; ++t) { o0[t] = silu_f(wb + w0 * rawel(r[t], 2 * c2) + w1 * rawel(r[t + 1], 2 * c2) + w2 * rawel(r[t + 2], 2 * c2) + w3 * rawel(r[t + 3], 2 * c2));
                    o1[t] = silu_f(vb + v0 * rawel(r[t], 2 * c2 + 1) + v1 * rawel(r[t + 1], 2 * c2 + 1) + v2 * rawel(r[t + 2], 2 * c2 + 1) + v3 * rawel(r[t + 3], 2 * c2 + 1)); }
                *(LAS u32x4*)(dst + (2 * c2) * 72) = pack8(o0); *(LAS u32x4*)(dst + (2 * c2 + 1) * 72) = pack8(o1);
#pragma unroll
                for (int t = 0; t < 8; ++t) rowpk[t][c2] = cvt_pk_bf16(o0[t], o1[t]);
            }
#pragma unroll
            for (int t = 0; t < 8; ++t) *(u32x4*)(gi + t * 136) = rowpk[t];
        }
        __syncthreads();
        {
            const int hl = wave >> 1, nh = wave & 1, h = 4 * g + hl;
            const float cdv = cdl2[pb * 4 + hl];
            if (!samp) {
                if (ci > 0) {
                bf16* sp = ST + ((size_t)cidx * 16 + h) * 8192;
#pragma unroll
                for (int i = 0; i < 4; ++i)
#pragma unroll
                    for (int j = 0; j < 4; ++j) { u32x2 w; w.x = cvt_pk_bf16(acc[i][j][0], acc[i][j][1]); w.y = cvt_pk_bf16(acc[i][j][2], acc[i][j][3]);
                        *(u32x2*)(sp + (16 * j + fr) * 128 + 64 * nh + 16 * i + 4 * fq) = w; }
                }
                if (nh == 0 && lane == 0) CDP[cidx * 16 + h] = cum;
#pragma unroll
                for (int i = 0; i < 4; ++i)
#pragma unroll
                    for (int j = 0; j < 4; ++j) acc[i][j] *= cdv;
                cum *= cdv;
            }
#pragma unroll
            for (int ks = 0; ks < 2; ++ks) {
                bf16x8 xf[4], yf[4];
#pragma unroll
                for (int i = 0; i < 4; ++i) xf[i] = *(const LAS bf16x8*)(BT + (64 * nh + 16 * i + fr) * 72 + 32 * ks + 8 * fq);
#pragma unroll
                for (int j = 0; j < 4; ++j) yf[j] = *(const LAS bf16x8*)(xsT + (64 * hl + 16 * j + fr) * 72 + 32 * ks + 8 * fq);
#pragma unroll
                for (int i = 0; i < 4; ++i)
#pragma unroll
                    for (int j = 0; j < 4; ++j) acc[i][j] = __builtin_amdgcn_mfma_f32_16x16x32_bf16(xf[i], yf[j], acc[i][j], 0, 0, 0);
            }
            if (samp) {
                const int b = cidx - 512;
                const float* s0 = a.in[I_SSM] + ((size_t)b * 16 + h) * 8192; float* so = a.out + O_SSMS + ((size_t)b * 16 + h) * 8192;
#pragma unroll
                for (int i = 0; i < 4; ++i)
#pragma unroll
                    for (int j = 0; j < 4; ++j) { const int off = (16 * j + fr) * 128 + 64 * nh + 16 * i + 4 * fq;
                        *(f32x4*)(so + off) = *(const f32x4*)(s0 + off) * cdv + acc[i][j]; }
            }
        }
        if (ci + 1 < nci) P3_DT(cidx + 1, g, pb ^ 1, dnext);
        __syncthreads();
      }
      if (!samp) {
          const int hl = wave >> 1, nh = wave & 1;
          bf16* sp = RA + ((size_t)rho * 4 + hl) * 8192;
#pragma unroll
          for (int i = 0; i < 4; ++i)
#pragma unroll
              for (int j = 0; j < 4; ++j) { u32x2 w; w.x = cvt_pk_bf16(acc[i][j][0], acc[i][j][1]); w.y = cvt_pk_bf16(acc[i][j][2], acc[i][j][3]);
                  *(u32x2*)(sp + (16 * j + fr) * 128 + 64 * nh + 16 * i + 4 * fq) = w; }
          if (nh == 0 && lane == 0) RD[rho * 4 + hl] = cum;
      }
    }
}

__device__ __forceinline__ void p4_scan(const Args& a, int bid, int G) {
    unsigned* RAw = (unsigned*)((unsigned char*)a.out + RA_OFF); const float* RD = (const float*)(a.ws + WS_RD);
    for (int idx = bid * NTHREADS + (int)threadIdx.x; idx < 8 * 16384; idx += G * NTHREADS) {
        const int sg = idx >> 14, e2 = idx & 16383, hl = e2 >> 12;
        float run0 = 0.f, run1 = 0.f;
        unsigned* p = RAw + (size_t)(sg * 32) * 16384 + e2; const float* rd = RD + (sg * 32) * 4 + hl;
        unsigned v[32]; float d[32];
#pragma unroll
        for (int k = 0; k < 32; ++k) { v[k] = p[(size_t)k * 16384]; d[k] = rd[k * 4]; }
#pragma unroll
        for (int k = 0; k < 32; ++k) { p[(size_t)k * 16384] = cvt_pk_bf16(run0, run1); run0 = run0 * d[k] + bflo(v[k]); run1 = run1 * d[k] + bfhi(v[k]); }
        *(f32x2*)(a.out + O_SSMP + (size_t)(sg >> 2) * 131072 + (size_t)(4 * (sg & 3) + hl) * 8192 + 2 * (e2 & 4095)) = (f32x2){run0, run1};
    }
}

__device__ __forceinline__ void p5_mix(const Args& a, LAS unsigned char* lds, int bid, int G) {
    int tid = threadIdx.x; asm volatile("" : "+v"(tid));
    const int lane = tid & 63, wave = __builtin_amdgcn_readfirstlane(tid >> 6), fr = lane & 15, fq = lane >> 4;
    bf16* ACT = (bf16*)(a.ws + WS_ACT); const bf16* XBC = (const bf16*)(a.ws + WS_XBC);
    const float* DTV = (const float*)(a.ws + WS_DTV); const float* ACU = (const float*)(a.ws + WS_ACU);
    const bf16* ST = (const bf16*)(a.ws + WS_ST); float* SS = (float*)(a.ws + WS_SS);
    LAS float* dtv = (LAS float*)lds; LAS float* acu = (LAS float*)(lds + 1024); LAS float* ea = (LAS float*)(lds + 2048);
    LAS float* partA = (LAS float*)(lds + 3072); LAS float* partB = (LAS float*)(lds + 3584);
    LAS bf16* xsT = (LAS bf16*)(lds + 8192); LAS bf16* Bn = (LAS bf16*)(lds + 45056); LAS bf16* Cn = (LAS bf16*)(lds + 62464); LAS bf16* Mh = (LAS bf16*)(lds + 79872);
    const bf16* XSI = (const bf16*)a.out; const bf16* BNI = (const bf16*)((const unsigned char*)a.out + BNI_OFF);
    const int tidp5_ = tid; const int cgc = tid & 15, rs2 = tid >> 4;
    u32x4 im[7], rc[5]; ConvW W; float dt_r, ac_r;
#define P5_LOADS(UNIT) do { const int u_ = (UNIT), cidx_ = u_ >> 2, q_ = u_ & 3; int tid = tidp5_; asm volatile("" : "+v"(tid));   \
        const int cgc = tid & 15, rs2 = tid >> 4, xcol_ = 1536 + 128 * q_ + 8 * cgc; \
        dt_r = DTV[(size_t)(cidx_ * 64 + ((tid & 255) >> 2)) * 16 + 4 * q_ + (tid & 3)]; ac_r = ACU[(size_t)(cidx_ * 64 + ((tid & 255) >> 2)) * 16 + 4 * q_ + (tid & 3)]; \
        const bool sample_ = cidx_ >= 512, first_ = !sample_ && (cidx_ & 255) == 0; \
        const u32x4* xi_ = (const u32x4*)(XSI + (size_t)u_ * XSI_UNIT); const u32x4* bi_ = (const u32x4*)(BNI + (size_t)u_ * BNI_UNIT); \
        _Pragma("unroll") for (int k = 0; k < 7; ++k) { const int idx = tid + NTHREADS * k; if (idx < 2304) im[k] = xi_[idx]; else if (idx < 3392) im[k] = bi_[idx - 2304]; } \
        const int tb_ = 2 * rs2 - 3; \
        _Pragma("unroll") for (int k = 0; k < 5; ++k) { const int tr = tb_ + k; \
            if (tr >= 0 || (!sample_ && !first_)) rc[k] = *(const u32x4*)(XBC + (size_t)(cidx_ * 64 + tr) * DXBC + xcol_); \
            else if (sample_) { const float* sp = a.in[I_SCB] + ((size_t)(cidx_ - 512) * 3 + (3 + tr)) * DXBC + xcol_; const f32x4 a0 = *(const f32x4*)sp, a1 = *(const f32x4*)(sp + 4); \
                rc[k].x = cvt_pk_bf16(a0[0], a0[1]); rc[k].y = cvt_pk_bf16(a0[2], a0[3]); rc[k].z = cvt_pk_bf16(a1[0], a1[1]); rc[k].w = cvt_pk_bf16(a1[2], a1[3]); } \
            else rc[k] = (u32x4){0u, 0u, 0u, 0u}; } \
        convw_load(a.in[I_CBW], a.in[I_CBB], xcol_, W); } while (0)
    if (bid < NCHUNK * 4) P5_LOADS(bid);
    for (int unit = bid; unit < NCHUNK * 4; unit += G) {
        const int cidx = unit >> 2, q = unit & 3, row0 = cidx * 64;
        const bool sample = cidx >= 512, first = !sample && (cidx & 255) == 0, lastc = sample || (cidx & 255) == 255;
        const int xcol = 1536 + 128 * q + 8 * cgc;
        if (tid < 256) { dtv[tid] = dt_r; acu[tid] = ac_r; ea[tid] = __expf(ac_r); }
#pragma unroll
        for (int k = 0; k < 7; ++k) { const int idx = tid + NTHREADS * k; if (idx < 2304) ((LAS u32x4*)xsT)[idx] = im[k]; else if (idx < 3392) ((LAS u32x4*)Bn)[idx - 2304] = im[k]; }
        if (lastc && rs2 == 31) {
            float* op = sample ? a.out + O_CBS + (size_t)(cidx - 512) * 3 * DXBC + xcol : a.out + O_CBP + (size_t)(cidx >> 8) * 3 * DXBC + xcol;
#pragma unroll
            for (int k = 0; k < 3; ++k) { *(f32x4*)(op + k * DXBC) = (f32x4){rawel(rc[2 + k], 0), rawel(rc[2 + k], 1), rawel(rc[2 + k], 2), rawel(rc[2 + k], 3)};
                *(f32x4*)(op + k * DXBC + 4) = (f32x4){rawel(rc[2 + k], 4), rawel(rc[2 + k], 5), rawel(rc[2 + k], 6), rawel(rc[2 + k], 7)}; }
        }
#pragma unroll
        for (int t = 0; t < 2; ++t) {
            float o[8];
#pragma unroll
            for (int c = 0; c < 8; ++c) {
                const float v = W.b[c >> 2][c & 3] + W.w[0][c >> 2][c & 3] * rawel(rc[t], c) + W.w[1][c >> 2][c & 3] * rawel(rc[t + 1], c) + W.w[2][c >> 2][c & 3] * rawel(rc[t + 2], c) + W.w[3][c >> 2][c & 3] * rawel(rc[t + 3], c);
                o[c] = silu_f(v);
            }
            *(LAS u32x4*)(Cn + (2 * rs2 + t) * 136 + 8 * cgc) = pack8(o);
        }
        WG_BAR();
        {
#pragma unroll 1
            for (int tt = 0; tt < 2; ++tt) {
                const int tile = wave * 2 + tt, it = tile >> 2, jt = tile & 3;
                if (jt > it) {
#pragma unroll
                    for (int hl = 0; hl < 4; ++hl) *(LAS u32x2*)(Mh + (hl * 64 + 16 * it + fr) * 72 + 16 * jt + 4 * fq) = (u32x2){0u, 0u};
                    continue;
                }
                f32x4 cb = (f32x4){0.f, 0.f, 0.f, 0.f};
#pragma unroll
                for (int ks = 0; ks < 4; ++ks) {
                    const bf16x8 xf = *(const LAS bf16x8*)(Bn + (16 * jt + fr) * 136 + 32 * ks + 8 * fq);
                    const bf16x8 yf = *(const LAS bf16x8*)(Cn + (16 * it + fr) * 136 + 32 * ks + 8 * fq);
                    cb = __builtin_amdgcn_mfma_f32_16x16x32_bf16(xf, yf, cb, 0, 0, 0);
                }
                const int i = 16 * it + fr, jb = 16 * jt + 4 * fq;
#pragma unroll
                for (int hl = 0; hl < 4; ++hl) {
                    const float ai = acu[i * 4 + hl], dsk = a.in[I_DSKIP][4 * q + hl];
                    float mv[4];
#pragma unroll
                    for (int jj = 0; jj < 4; ++jj) { const int j = jb + jj;
                        float v = (i >= j) ? cb[jj] * __expf(ai - acu[j * 4 + hl]) * dtv[j * 4 + hl] : 0.f;
                        if (i == j) v += dsk;
                        mv[jj] = v; }
                    u32x2 w; w.x = cvt_pk_bf16(mv[0], mv[1]); w.y = cvt_pk_bf16(mv[2], mv[3]);
                    *(LAS u32x2*)(Mh + (hl * 64 + i) * 72 + jb) = w;
                }
            }
        }
        WG_BAR();
            const int ca = lane & 31, ra = 2 * wave + (lane >> 5), ja = 256 * q + 8 * ca, ta = 4 * ra;
            u32x4 ur[6], br[4];
        {
            const int hl = wave >> 1, ph = wave & 1, h = 4 * q + hl;
            float ssqa[4] = {0.f, 0.f, 0.f, 0.f};
            const bool haslp = sample || (cidx & 7) != 0;
#pragma unroll 1
            for (int ptl = 0; ptl < 2; ++ptl) {
                const int p0 = 32 * ph + 16 * ptl;
                bf16x8 sf[4], lf[4]; float cdp = 0.f;
                if (!sample) {
                    const int rho = ((cidx >> 8) * 4 + q) * 32 + ((cidx & 255) >> 3);
                    const bf16* sr = (const bf16*)((const unsigned char*)a.out + RA_OFF) + ((size_t)rho * 4 + hl) * 8192 + (p0 + fr) * 128 + 8 * fq;
                    const bf16* sp = ST + ((size_t)cidx * 16 + h) * 8192 + (p0 + fr) * 128 + 8 * fq;
#pragma unroll
                    for (int ks = 0; ks < 4; ++ks) { sf[ks] = *(const bf16x8*)(sr + 32 * ks); if (haslp) lf[ks] = *(const bf16x8*)(sp + 32 * ks); }
                    cdp = ((const float*)(a.ws + WS_CDP))[cidx * 16 + h];
                } else {
                    const float* sp = a.in[I_SSM] + ((size_t)(cidx - 512) * 16 + h) * 8192 + (p0 + fr) * 128 + 8 * fq;
#pragma unroll
                    for (int ks = 0; ks < 4; ++ks) { const f32x4 v0 = *(const f32x4*)(sp + 32 * ks), v1 = *(const f32x4*)(sp + 32 * ks + 4);
                        u32x4 w; w.x = cvt_pk_bf16(v0[0], v0[1]); w.y = cvt_pk_bf16(v0[2], v0[3]); w.z = cvt_pk_bf16(v1[0], v1[1]); w.w = cvt_pk_bf16(v1[2], v1[3]);
                        lf[ks] = __builtin_bit_cast(bf16x8, w); }
                }
                bf16* zp0 = ACT + (size_t)(row0 + fr) * LDACT + 2048 + 256 * q + 64 * hl + p0 + 4 * fq;
                u32x2 zw[4];
#pragma unroll
                for (int il = 0; il < 4; ++il) zw[il] = *(const u32x2*)(zp0 + (size_t)(16 * il) * LDACT);
                const f32x4 nw4 = *(const f32x4*)(a.in[I_NBW] + 256 * q + 64 * hl + p0 + 4 * fq);
                f32x4 ad[4], ao[4];
#pragma unroll
                for (int il = 0; il < 4; ++il) { ad[il] = (f32x4){0.f, 0.f, 0.f, 0.f}; ao[il] = (f32x4){0.f, 0.f, 0.f, 0.f}; }
#pragma unroll
                for (int ks = 0; ks < 2; ++ks) {
                    const bf16x8 xf = *(const LAS bf16x8*)(xsT + (64 * hl + p0 + fr) * 72 + 32 * ks + 8 * fq);
#pragma unroll
                    for (int il = 0; il < 4; ++il) ad[il] = __builtin_amdgcn_mfma_f32_16x16x32_bf16(xf, *(const LAS bf16x8*)(Mh + (hl * 64 + 16 * il + fr) * 72 + 32 * ks + 8 * fq), ad[il], 0, 0, 0);
                }
                if (!sample) {
#pragma unroll
                    for (int ks = 0; ks < 4; ++ks)
#pragma unroll
                        for (int il = 0; il < 4; ++il) ao[il] = __builtin_amdgcn_mfma_f32_16x16x32_bf16(sf[ks], *(const LAS bf16x8*)(Cn + (16 * il + fr) * 136 + 32 * ks + 8 * fq), ao[il], 0, 0, 0);
#pragma unroll
                    for (int il = 0; il < 4; ++il) ao[il] *= cdp;
                }
                if (haslp) {
#pragma unroll
                for (int ks = 0; ks < 4; ++ks)
#pragma unroll
                    for (int il = 0; il < 4; ++il) ao[il] = __builtin_amdgcn_mfma_f32_16x16x32_bf16(lf[ks], *(const LAS bf16x8*)(Cn + (16 * il + fr) * 136 + 32 * ks + 8 * fq), ao[il], 0, 0, 0);
                }
#pragma unroll
                for (int il = 0; il < 4; ++il) {
                    const float eai = ea[(16 * il + fr) * 4 + hl];
                    const u32x2 zv = zw[il];
                    const f32x4 y = ad[il] + ao[il] * eai;
                    const float g0 = y[0] * silu_f(bflo(zv.x)), g1 = y[1] * silu_f(bfhi(zv.x)), g2 = y[2] * silu_f(bflo(zv.y)), g3 = y[3] * silu_f(bfhi(zv.y));
                    ssqa[il] += (g0 * g0 + g1 * g1) + (g2 * g2 + g3 * g3);
                    u32x2 w; w.x = cvt_pk_bf16(g0 * nw4[0], g1 * nw4[1]); w.y = cvt_pk_bf16(g2 * nw4[2], g3 * nw4[3]);
                    *(u32x2*)(zp0 + (size_t)(16 * il) * LDACT) = w;
                }
            }
#pragma unroll
            for (int il = 0; il < 4; ++il) { float ssq = ssqa[il]; ssq += __shfl_xor(ssq, 16); ssq += __shfl_xor(ssq, 32); if (fq == 0) partB[wave * 64 + 16 * il + fr] = ssq; }
            __builtin_amdgcn_sched_barrier(0);
#pragma unroll
            for (int k = 0; k < 4; ++k) { ur[k + 2] = *(const u32x4*)(ACT + (size_t)(row0 + ta + k) * LDACT + ja); br[k] = *(const u32x4*)(ACT + (size_t)(row0 + ta + k) * LDACT + 1024 + ja); }
            if (ra > 0 || (!sample && !first)) {
#pragma unroll
                for (int k = 0; k < 2; ++k) ur[k] = *(const u32x4*)(ACT + (size_t)(row0 + ta - 2 + k) * LDACT + ja);
            } else if (sample) {
                const float* p = a.in[I_SCA] + (size_t)(cidx - 512) * 2 * D + ja;
#pragma unroll
                for (int k = 0; k < 2; ++k) { const f32x4 x0 = *(const f32x4*)(p + k * D), x1 = *(const f32x4*)(p + k * D + 4);
                    ur[k].x = cvt_pk_bf16(x0[0], x0[1]); ur[k].y = cvt_pk_bf16(x0[2], x0[3]); ur[k].z = cvt_pk_bf16(x1[0], x1[1]); ur[k].w = cvt_pk_bf16(x1[2], x1[3]); }
            } else { ur[0] = (u32x4){0u, 0u, 0u, 0u}; ur[1] = ur[0]; }

        }
        {
            const float* caw = a.in[I_CAW];
            f32x4 w0[2], w1[2], w2[2], nw[2];
#pragma unroll
            for (int hh = 0; hh < 2; ++hh) { w0[hh] = *(const f32x4*)(caw + ja + 4 * hh); w1[hh] = *(const f32x4*)(caw + D + ja + 4 * hh); w2[hh] = *(const f32x4*)(caw + 2 * D + ja + 4 * hh); nw[hh] = *(const f32x4*)(a.in[I_NAW] + ja + 4 * hh); }
#pragma unroll
            for (int k = 0; k < 4; ++k) {
                float y[8], ssq = 0.f;
#pragma unroll
                for (int c = 0; c < 8; ++c) {
                    const float v = rawel(br[k], c) * (w0[c >> 2][c & 3] * rawel(ur[k], c) + w1[c >> 2][c & 3] * rawel(ur[k + 1], c) + w2[c >> 2][c & 3] * rawel(ur[k + 2], c));
                    ssq += v * v; y[c] = v * nw[c >> 2][c & 3];
                }
                *(u32x4*)(ACT + (size_t)(row0 + ta + k) * LDACT + 1024 + ja) = pack8(y);
#pragma unroll
                for (int o = 1; o < 32; o <<= 1) ssq += __shfl_xor(ssq, o);
                if (ca == 0) partA[ta + k] = ssq;
            }
            if (lastc && ra == 15) {
                float* o = sample ? a.out + O_CAS + (size_t)(cidx - 512) * 2 * D + ja : a.out + O_CAP + (size_t)(cidx >> 8) * 2 * D + ja;
#pragma unroll
                for (int k = 0; k < 2; ++k) { *(f32x4*)(o + k * D) = (f32x4){rawel(ur[4 + k], 0), rawel(ur[4 + k], 1), rawel(ur[4 + k], 2), rawel(ur[4 + k], 3)};
                    *(f32x4*)(o + k * D + 4) = (f32x4){rawel(ur[4 + k], 4), rawel(ur[4 + k], 5), rawel(ur[4 + k], 6), rawel(ur[4 + k], 7)}; }
            }
        }
        __builtin_amdgcn_sched_barrier(0);
        __builtin_amdgcn_sched_barrier(0);
        P5_LOADS(unit + G < NCHUNK * 4 ? unit + G : unit);
        WG_BAR();
        if (tid < 64) { SS[(size_t)(row0 + tid) * 8 + q] = partA[tid];
            SS[(size_t)(row0 + tid) * 8 + 4 + q] = ((partB[tid] + partB[64 + tid]) + (partB[128 + tid] + partB[192 + tid])) + ((partB[256 + tid] + partB[320 + tid]) + (partB[384 + tid] + partB[448 + tid])); }
    }
}

__device__ __forceinline__ void p7_final(const Args& a, int bid, int G) {
    int tid = threadIdx.x; asm volatile("" : "+v"(tid));
    const int lane = tid & 63, wave = tid >> 6;
    f32x4 nw[4];
#pragma unroll
    for (int j = 0; j < 4; ++j) nw[j] = ((const f32x4*)a.in[I_NFW])[lane + 64 * j];
    for (int row = bid * 8 + wave; row < MT; row += G * 8) {
        f32x4* yr = (f32x4*)(a.out + (size_t)row * D);
        f32x4 v[4]; float ss = 0.f;
        if (row < MP) {
            const f32x4* xi = (const f32x4*)(a.in[I_XP] + (size_t)row * D); const u32x2* dl = (const u32x2*)((const bf16*)(a.ws + WS_DELTA) + (size_t)row * D);
#pragma unroll
            for (int j = 0; j < 4; ++j) { const u32x2 d = dl[lane + 64 * j]; v[j] = xi[lane + 64 * j] + (f32x4){bflo(d.x), bfhi(d.x), bflo(d.y), bfhi(d.y)}; }
        } else {
            const f32x4* xi = (const f32x4*)(a.in[I_XS] + (size_t)(row - MP) * D); const f32x4* os = (const f32x4*)(a.ws + WS_OUTS) + (size_t)(row - MP) * (D / 4);
            const f32x4* gp = (const f32x4*)((const float*)(a.ws + WS_MOD) + seq_of_row(row) * 3072 + 2048);
#pragma unroll
            for (int j = 0; j < 4; ++j) { f32x4 o = os[lane + 64 * j];
#pragma unroll
                for (int sl = 1; sl < 8; ++sl) o += os[(size_t)sl * MS * (D / 4) + lane + 64 * j];
                v[j] = xi[lane + 64 * j] + gp[lane + 64 * j] * o; }
        }
#pragma unroll
        for (int j = 0; j < 4; ++j) ss += (v[j][0] * v[j][0] + v[j][1] * v[j][1]) + (v[j][2] * v[j][2] + v[j][3] * v[j][3]);
        const float rstd = rsqrtf(wave_sum(ss) * (1.f / D) + EPS);
#pragma unroll
        for (int j = 0; j < 4; ++j) yr[lane + 64 * j] = v[j] * rstd * nw[j];
    }
}

#define XB_TMO      128
#define XB_XCNT(j)  (256  + 64 * (j))
#define XB_XSUB(j)  (1280 + 64 * (j))
#define XB_XGEN(j)  (2304 + 64 * (j))
#define XB_TOP      3328
#define XB_TOPGEN   3392
#define XCD_BAR_WORDS 3456
#define XB_SPIN_CAP (1u << 18)
__device__ __forceinline__ unsigned xb_ld(unsigned* p)              { return __hip_atomic_load(p, __ATOMIC_RELAXED, __HIP_MEMORY_SCOPE_AGENT); }
__device__ __forceinline__ unsigned xb_add(unsigned* p, unsigned v) { return __hip_atomic_fetch_add(p, v, __ATOMIC_RELAXED, __HIP_MEMORY_SCOPE_AGENT); }
__device__ __forceinline__ unsigned xb_xcc_id() { return (unsigned)__builtin_amdgcn_s_getreg((3 << 11) | 20) & 0xFu; }
#define XB_SPIN(cond, bar) do { unsigned _sp = 0; while (cond) { __builtin_amdgcn_s_sleep(1); \
    if ((++_sp & 255u) == 0u) { if (xb_ld(&(bar)[XB_TMO])) break; if (_sp > XB_SPIN_CAP) { atomicAdd(&(bar)[XB_TMO], 1u); break; } } } } while (0)
struct XcdBarrier { unsigned* bar; unsigned x; volatile LAS unsigned* st; };
__device__ __forceinline__ XcdBarrier xcd_barrier_post(unsigned* bar, volatile LAS unsigned* st) {
    XcdBarrier b; b.bar = bar; b.x = xb_xcc_id(); b.st = st;
    if (threadIdx.x == 0) (void)xb_add(&bar[XB_XCNT(b.x)], 1u);
    return b;
}
__device__ __forceinline__ void xcd_barrier_complete(unsigned* bar, unsigned x, unsigned& nloc, unsigned& nx) {
    const unsigned G = gridDim.x * gridDim.y * gridDim.z;
    unsigned sum, cnt, mine, sp = 0u;
    for (;;) {
        sum = 0u; cnt = 0u; mine = 0u;
#pragma unroll
        for (unsigned j = 0; j < 16; ++j) { const unsigned c = xb_ld(&bar[XB_XCNT(j)]); sum += c; cnt += (c > 0u) ? 1u : 0u; mine = (j == x) ? c : mine; }
        if (sum == G) break;
        __builtin_amdgcn_s_sleep(1);
        if ((++sp & 255u) == 0u) { if (xb_ld(&bar[XB_TMO])) break; if (sp > XB_SPIN_CAP) { atomicAdd(&bar[XB_TMO], 1u); break; } }
    }
    nloc = mine > 0u ? mine : 1u; nx = cnt > 0u ? cnt : 1u;
}
__device__ __forceinline__ void xcd_barrier(unsigned* bar_, volatile LAS unsigned* st_) {
    XcdBarrier b; b.bar = bar_; b.x = xb_xcc_id(); b.st = st_;
    asm volatile("s_waitcnt vmcnt(0)" ::: "memory");
    __syncthreads();
    if (threadIdx.x == 0) {
        unsigned* bar = b.bar;
        __builtin_amdgcn_s_waitcnt(0);
        unsigned nloc = b.st[0], nx = b.st[1];
        if (nloc == 0u) { xcd_barrier_complete(bar, b.x, nloc, nx); b.st[0] = nloc; b.st[1] = nx; }
        const unsigned old = xb_add(&bar[XB_XSUB(b.x)], 1u);
        const unsigned gen = old / nloc;
        if (old + 1u == (gen + 1u) * nloc) {
            __builtin_amdgcn_fence(__ATOMIC_RELEASE, "agent");
            asm volatile("s_waitcnt vmcnt(0)" ::: "memory");
            const unsigned og = xb_add(&bar[XB_TOP], 1u);
            const unsigned tg = og / nx;
            if (og + 1u == (tg + 1u) * nx) xb_add(&bar[XB_TOPGEN], 1u);
            else XB_SPIN(xb_ld(&bar[XB_TOPGEN]) == tg, bar);
            __builtin_amdgcn_fence(__ATOMIC_ACQUIRE, "agent");
            xb_add(&bar[XB_XGEN(b.x)], 1u);
            asm volatile("s_waitcnt vmcnt(0)" ::: "memory");
        } else {
            XB_SPIN(xb_ld(&bar[XB_XGEN(b.x)]) == gen, bar);
            __builtin_amdgcn_fence(__ATOMIC_ACQUIRE, "agent");
            asm volatile("s_waitcnt vmcnt(0)" ::: "memory");
        }
    }
    __syncthreads();
}

__global__ void __launch_bounds__(NTHREADS, 2) mk_fwd(Args a) {
    extern __shared__ __attribute__((aligned(16))) unsigned char lds_raw[];
    LAS unsigned char* lds = (LAS unsigned char*)lds_raw;
    cg::grid_group grid = cg::this_grid();
    const int bid = blockIdx.x, G = gridDim.x;
    volatile LAS unsigned* bst = (volatile LAS unsigned*)(lds + LDS_BYTES - 64);
    if (threadIdx.x < 2) bst[threadIdx.x] = 0u;
    __syncthreads();
    (void)xcd_barrier_post((unsigned*)(a.ws + WS_BAR), bst);
    if (a.pad0 != 0) grid.sync();
#define RUN_P0 p0_prologue(a, lds, bid, G)
#define RUN_P1 do { p1_transposes(a, lds, bid, G); p1_norm(a, bid, G); } while (0)
#define RUN_P2 do { pg8::Gemm g{(const bf16*)a.out, (const bf16*)(a.ws + WS_WTIN), MT, NINP, D, D}; \
        pg8::StaticOrder S; S.init(MT, NINP, D, G, bid); \
        pg8::EpiIn E{(bf16*)(a.ws + WS_ACT), (bf16*)(a.ws + WS_XBC), (float*)(a.ws + WS_DTR)}; \
        pg8::gemm_phase<pg8::EpiIn, pg8::StaticOrder>(lds, g, S, E); } while (0)
#define RUN_P3 p3_states(a, lds, bid, G)
#define RUN_P4 p4_scan(a, bid, G)
#define RUN_P5 p5_mix(a, lds, bid, G)
#define RUN_P6 do { pg8::Gemm g{(const bf16*)(a.ws + WS_ACT) + 1024, (const bf16*)(a.ws + WS_WTOUT), MT, D, 2048, LDACT}; \
        pg8::SplitOrder S; S.init(G, bid); \
        pg8::EpiOut E{(const float*)(a.ws + WS_MOD), (const float*)(a.ws + WS_SS), (bf16*)(a.ws + WS_DELTA), (float*)(a.ws + WS_OUTS)}; \
        pg8::gemm_phase<pg8::EpiOut, pg8::SplitOrder>(lds, g, S, E); } while (0)
#define RUN_P7 p7_final(a, bid, G)
#define SYNC xcd_barrier((unsigned*)(a.ws + WS_BAR), (volatile LAS unsigned*)(lds + LDS_BYTES - 64))
    RUN_P0; SYNC; RUN_P1; SYNC; RUN_P2; SYNC; RUN_P3; SYNC; RUN_P4; SYNC; RUN_P5; SYNC; RUN_P6; SYNC; RUN_P7;
}

#ifdef PROBE_LIST
template <int PH> __global__ void __launch_bounds__(NTHREADS, 2) mk_one(Args a) {
    extern __shared__ __attribute__((aligned(16))) unsigned char lds_raw[];
    LAS unsigned char* lds = (LAS unsigned char*)lds_raw;
    const int bid = blockIdx.x, G = gridDim.x;
    if constexpr (PH == 0) p0_prologue(a, lds, bid, G);
    if constexpr (PH == 1) { p1_transposes(a, lds, bid, G); p1_norm(a, bid, G); }
    if constexpr (PH == 2) { pg8::Gemm g{(const bf16*)a.out, (const bf16*)(a.ws + WS_WTIN), MT, NINP, D, D};
        pg8::StaticOrder S; S.init(MT, NINP, D, G, bid);
        pg8::EpiIn E{(bf16*)(a.ws + WS_ACT), (bf16*)(a.ws + WS_XBC), (float*)(a.ws + WS_DTR)};
        pg8::gemm_phase<pg8::EpiIn, pg8::StaticOrder>(lds, g, S, E); }
    if constexpr (PH == 3) p3_states(a, lds, bid, G);
    if constexpr (PH == 4) p4_scan(a, bid, G);
    if constexpr (PH == 5) p5_mix(a, lds, bid, G);
    if constexpr (PH == 6) { pg8::Gemm g{(const bf16*)(a.ws + WS_ACT) + 1024, (const bf16*)(a.ws + WS_WTOUT), MT, D, 2048, LDACT};
        pg8::SplitOrder S; S.init(G, bid);
        pg8::EpiOut E{(const float*)(a.ws + WS_MOD), (const float*)(a.ws + WS_SS), (bf16*)(a.ws + WS_DELTA), (float*)(a.ws + WS_OUTS)};
        pg8::gemm_phase<pg8::EpiOut, pg8::SplitOrder>(lds, g, S, E); }
    if constexpr (PH == 7) p7_final(a, bid, G);
}
template <int PH> static void launch_one(const Args& a, int grid, hipStream_t stream) {
    static bool init = false;
    if (!init) { (void)hipFuncSetAttribute((const void*)mk_one<PH>, hipFuncAttributeMaxDynamicSharedMemorySize, LDS_BYTES); init = true; }
    hipLaunchKernelGGL(mk_one<PH>, dim3(grid), dim3(NTHREADS), LDS_BYTES, stream, a);
}
#endif

extern "C" void kernel_launch(void* const* d_in, const int* in_sizes, int n_in, void* d_out, int out_size, void* d_ws, size_t ws_size, hipStream_t stream) {
    static int grid = 0;
    if (grid == 0) {
        if (n_in != 21 || out_size != (int)O_END || ws_size < WS_END) { fprintf(stderr, "kernel_launch: unexpected sizes n_in %d out %d ws %zu\n", n_in, out_size, ws_size); grid = -1; return; }
        int dev = 0, cus = 0, per_cu = 0;
        hipGetDevice(&dev);
        hipDeviceGetAttribute(&cus, hipDeviceAttributeMultiprocessorCount, dev);
        hipFuncSetAttribute((const void*)mk_fwd, hipFuncAttributeMaxDynamicSharedMemorySize, LDS_BYTES);
        hipOccupancyMaxActiveBlocksPerMultiprocessor(&per_cu, (const void*)mk_fwd, NTHREADS, LDS_BYTES);
        if (per_cu < 1) { fprintf(stderr, "kernel_launch: occupancy query says %d blocks per CU\n", per_cu); grid = -1; return; }
        grid = cus;
    }
    if (grid < 0) return;
    Args a{};
    for (int i = 0; i < 21; ++i) a.in[i] = (const float*)d_in[i];
    a.out = (float*)d_out; a.ws = (unsigned char*)d_ws;
#ifdef PROBE_LIST
    const int plist[] = PROBE_LIST;
    for (int ph : plist) {
        switch (ph) { case 0: launch_one<0>(a, grid, stream); break; case 1: launch_one<1>(a, grid, stream); break; case 2: launch_one<2>(a, grid, stream); break; case 3: launch_one<3>(a, grid, stream); break;
            case 4: launch_one<4>(a, grid, stream); break; case 5: launch_one<5>(a, grid, stream); break; case 6: launch_one<6>(a, grid, stream); break; default: launch_one<7>(a, grid, stream); break; }
    }
#else
    (void)hipMemsetAsync((char*)d_ws + WS_BAR, 0, XCD_BAR_WORDS * 4, stream);
    void* args[] = {&a};
    hipError_t e = hipLaunchCooperativeKernel((const void*)mk_fwd, dim3(grid), dim3(NTHREADS), args, LDS_BYTES, stream);
    if (e != hipSuccess) fprintf(stderr, "cooperative launch failed: %s\n", hipGetErrorString(e));
#endif
}
```

```cpp
#include <hip/hip_runtime.h>
#include <hip/hip_cooperative_groups.h>
#include <cstdio>
#include <cstdint>
namespace cg = cooperative_groups;


#define LAS __attribute__((address_space(3)))
typedef unsigned short bf16;
typedef short bf16x8 __attribute__((ext_vector_type(8)));
typedef float f32x4 __attribute__((ext_vector_type(4)));
typedef float f32x2 __attribute__((ext_vector_type(2)));
typedef unsigned u32x4 __attribute__((ext_vector_type(4)));
typedef unsigned u32x2 __attribute__((ext_vector_type(2)));

constexpr int D = 1024, MP = 32768, MS = 1024, MT = MP + MS;
constexpr int NSEQ = 18, NCHUNK = MT / 64;
constexpr int NIN = 7184, NINP = 7424;
constexpr int DXBC = 2048, LDACT = 3072;
constexpr float EPS = 1e-5f;
constexpr int NTHREADS = 512;
constexpr int LDS_BYTES = 147456;

constexpr size_t MiB = 1u << 20;
constexpr size_t WS_MOD = 0;
constexpr size_t WS_WTIN = 1 * MiB;
constexpr size_t WS_WTOUT = 16 * MiB;
constexpr size_t WS_SS = 20 * MiB;
constexpr size_t WS_SSF = 22 * MiB;
constexpr size_t WS_CD = 25 * MiB;
constexpr size_t WS_DTR = 26 * MiB;
constexpr size_t WS_DTV = 29 * MiB;
constexpr size_t WS_ACU = 32 * MiB;
constexpr size_t WS_BAR = 35 * MiB;
constexpr size_t WS_ACT = 36 * MiB;
constexpr size_t WS_XBC = 234 * MiB;
constexpr size_t WS_ST = 366 * MiB;
constexpr size_t WS_OUTS = WS_XBC;
constexpr size_t WS_DELTA = WS_XBC + 32 * MiB;
constexpr size_t WS_END = 498 * MiB;
constexpr int XSI_UNIT = 256 * 72, BNI_UNIT = 64 * 136;
constexpr size_t BNI_OFF = 80 * MiB;
constexpr int NRUN = 256;
constexpr size_t RA_OFF = 116 * MiB;
constexpr size_t WS_RD = 25 * MiB + 64 * 1024;
constexpr size_t WS_CDP = 25 * MiB + 128 * 1024;

#define NT_ST(ptr, val) __builtin_nontemporal_store((val), (ptr))
#define NT_LD(ptr) __builtin_nontemporal_load(ptr)
__device__ __forceinline__ unsigned cvt_pk_bf16(float lo, float hi) { unsigned r; asm volatile("v_cvt_pk_bf16_f32 %0, %1, %2" : "=v"(r) : "v"(lo), "v"(hi)); return r; }
__device__ __forceinline__ float bf2f(unsigned b) { return __uint_as_float(b << 16); }
__device__ __forceinline__ float bflo(unsigned w) { return __uint_as_float(w << 16); }
__device__ __forceinline__ float bfhi(unsigned w) { return __uint_as_float(w & 0xffff0000u); }
__device__ __forceinline__ float silu_f(float v) { return v * __builtin_amdgcn_rcpf(1.f + __expf(-v)); }
__device__ __forceinline__ float wave_sum(float v) {
#pragma unroll
    for (int o = 1; o < 64; o <<= 1) v += __shfl_xor(v, o);
    return v;
}
__device__ __forceinline__ int seq_of_row(int row) { return row < MP ? (row >> 14) : 2 + ((row - MP) >> 6); }

namespace pg8 {
constexpr int BM = 256, BK = 64, HALF = 128, HTB = HALF * BK * 2, STAGE_BYTES = 8 * HTB, NXCD = 8, WGM = 8;
__host__ __device__ __forceinline__ int lds_byte(int r, int c) { const int st = (r >> 4) * 2 + (c >> 5), rr = r & 15, cc = c & 31, ob = rr * 64 + cc * 2; return st * 1024 + (ob ^ (((ob >> 9) & 1) << 5)); }
__host__ __device__ __forceinline__ void stage_rc(int b, int& R, int& C) { const int st = b / 1024, sb = b % 1024, swz = sb ^ (((sb >> 9) & 1) << 5); R = (st >> 1) * 16 + swz / 64; C = (st & 1) * 32 + (swz % 64) / 2; }
__host__ __device__ __forceinline__ int perm32(int rho) { const int n = rho >> 4, i = rho & 15; return 8 * (i >> 2) + 4 * n + (i & 3); }
struct Unit { int pm, pn, k0, nt; };
struct Gemm { const bf16* A; const bf16* Bt; int M, N, K, lda; };
struct StaticOrder {
    int nM, nN, nwg, G, c, ntf;
    __device__ void init(int M, int N, int K, int G_, int c_) { nM = M / BM; nN = N / BM; nwg = nM * nN; G = G_; c = c_; ntf = K / BK; }
    __device__ bool next(int i, Unit& u) const {
        const long L = (long)i * G + c; if (L >= nwg) return false;
        u.k0 = 0; u.nt = ntf;
        int wgid = (int)L; { const int q = nwg / NXCD, r = nwg % NXCD, xcd = wgid % NXCD, off = wgid / NXCD; wgid = (xcd < r ? xcd * (q + 1) : r * (q + 1) + (xcd - r) * q) + off; }
        const int nig = WGM * nN, gid = wgid / nig, fm = gid * WGM, gsz = (nM - fm) < WGM ? (nM - fm) : WGM;
        u.pm = fm + ((wgid % nig) % gsz); u.pn = (wgid % nig) / gsz; return true;
    }
};

struct SplitOrder {
    StaticOrder main; int nmain, G, c;
    __device__ void init(int G_, int c_) { main.init(MP, D, 2048, G_, c_); nmain = main.nwg; G = G_; c = c_; }
    __device__ bool next(int i, Unit& u) const {
        const long L = (long)i * G + c;
        if (L < nmain) return main.next(i, u);
        const int r = (int)(L - nmain); if (r >= 128) return false;
        u.pm = MP / BM + (r >> 5); u.pn = (r & 31) >> 3; u.k0 = (r & 7) * 256; u.nt = 4; return true;
    }
};

template <class Epi, class Order>
__device__ __forceinline__ void gemm_phase(LAS unsigned char* lds, const Gemm g, const Order& S, const Epi& E) {
    int tid = threadIdx.x; asm volatile("" : "+v"(tid));
    const int wid = __builtin_amdgcn_readfirstlane(tid >> 6), lane = tid & 63, wr = wid >> 2, wc = wid & 3, fr = lane & 15, fq = lane >> 4;
    const int K = g.K, lda = g.lda;
    unsigned voffA[2], voffB[2];
#pragma unroll
    for (int i = 0; i < 2; ++i) { int R, C; stage_rc(tid * 16 + i * 8192, R, C); const int Rb = Epi::PERM ? ((R & ~31) + perm32(R & 31)) : R;
        voffA[i] = (unsigned)(R * lda + C) * 2u; voffB[i] = (unsigned)(Rb * K + C) * 2u; }
    const size_t kstep = (size_t)(BK * 2);
    const size_t hstepA = (size_t)HALF * lda * 2, tstepA = 2 * hstepA;
    const size_t hstepB = (size_t)HALF * K * 2, tstepB = 2 * hstepB;
    const unsigned ldsw = (unsigned)wid * 1024u;
    const int aoff = lds_byte(wr * 64 + fr, fq * 8), boff = lds_byte(wc * 32 + fr, fq * 8);
#define PG8_SA(b, h) (((b) * 2 + (h)) * HTB)
#define PG8_SB(b, h) ((4 + (b) * 2 + (h)) * HTB)
#define PG8_STAGE(bufoff, gbase, voff) do { _Pragma("unroll") for (int _i = 0; _i < 2; ++_i) \
        __builtin_amdgcn_global_load_lds((const unsigned*)((const char*)(gbase) + (voff)[_i]), (LAS unsigned*)(lds + (bufoff) + ldsw + _i * 8192), 16, 0, 0); } while (0)
#define PG8_LDA(dst, b, h) do { _Pragma("unroll") for (int m = 0; m < 4; ++m) _Pragma("unroll") for (int k = 0; k < 2; ++k) dst[m][k] = *(const LAS bf16x8*)(lds + PG8_SA(b, h) + aoff + m * 2048 + k * 1024); } while (0)
#define PG8_LDB(dst, b, h) do { _Pragma("unroll") for (int n = 0; n < 2; ++n) _Pragma("unroll") for (int k = 0; k < 2; ++k) dst[n][k] = *(const LAS bf16x8*)(lds + PG8_SB(b, h) + boff + n * 2048 + k * 1024); } while (0)
#define PG8_MMA(ai, bj, At, Bt) do { __builtin_amdgcn_s_setprio(1); _Pragma("unroll") for (int m = 0; m < 4; ++m) _Pragma("unroll") for (int n = 0; n < 2; ++n) _Pragma("unroll") for (int k = 0; k < 2; ++k) \
        acc[ai][bj][m][n] = __builtin_amdgcn_mfma_f32_16x16x32_bf16(Bt[n][k], At[m][k], acc[ai][bj][m][n], 0, 0, 0); __builtin_amdgcn_s_setprio(0); } while (0)
#define PG8_WAIT_V(n) asm volatile("s_waitcnt vmcnt(" #n ")" ::: "memory")
#define PG8_WAIT_L(n) asm volatile("s_waitcnt lgkmcnt(" #n ")" ::: "memory")
#define PG8_BAR __builtin_amdgcn_s_barrier()
#define PG8_SCHED __builtin_amdgcn_sched_barrier(0)
    Unit cur, nxt; int ui = 0;
    if (!S.next(0, cur)) return;
    f32x4 acc[2][2][4][2];
#pragma unroll
    for (int a = 0; a < 2; ++a)
#pragma unroll
        for (int b = 0; b < 2; ++b)
#pragma unroll
            for (int m = 0; m < 4; ++m)
#pragma unroll
                for (int n = 0; n < 2; ++n) acc[a][b][m][n] = (f32x4){0.f, 0.f, 0.f, 0.f};
    bf16x8 At[4][2], B0[2][2], B1[2][2];
    const char* cA = (const char*)g.A + (size_t)cur.pm * tstepA + (size_t)cur.k0 * 2; const char* cB = (const char*)g.Bt + (size_t)cur.pn * tstepB + (size_t)cur.k0 * 2;
    PG8_STAGE(PG8_SB(0, 0), cB, voffB); PG8_STAGE(PG8_SA(0, 0), cA, voffA); PG8_STAGE(PG8_SB(0, 1), cB + hstepB, voffB); PG8_STAGE(PG8_SA(0, 1), cA + hstepA, voffA);
    if (wr == 1) PG8_BAR;
    PG8_WAIT_V(4); PG8_BAR;
    PG8_STAGE(PG8_SB(1, 0), cB + kstep, voffB); PG8_STAGE(PG8_SA(1, 0), cA + kstep, voffA); PG8_STAGE(PG8_SB(1, 1), cB + hstepB + kstep, voffB);
    PG8_WAIT_V(6); PG8_BAR;
    for (;;) {
        const bool has_next = S.next(ui + 1, nxt);
        const char* nA = has_next ? (const char*)g.A + (size_t)nxt.pm * tstepA + (size_t)nxt.k0 * 2 : cA; const char* nB = has_next ? (const char*)g.Bt + (size_t)nxt.pn * tstepB + (size_t)nxt.k0 * 2 : cB;
        const int nt = cur.nt;
        for (int t = 0; t < nt; t += 2) {
            const bool last = (t == nt - 2);
            const char* a1 = cA + (size_t)(t + 1) * kstep;
            const char* a2 = last ? nA : cA + (size_t)(t + 2) * kstep; const char* b2 = last ? nB : cB + (size_t)(t + 2) * kstep;
            const char* a3 = a2 + kstep; const char* b3 = b2 + kstep;
            if constexpr (Epi::HAS_MID) { if (t == 16 && nt == 32) E.mid(acc, cur, wr, fr); }
            PG8_LDB(B0, 0, 0); PG8_SCHED; PG8_LDA(At, 0, 0); PG8_STAGE(PG8_SA(1, 1), a1 + hstepA, voffA);
            PG8_WAIT_L(8); PG8_BAR; PG8_WAIT_L(0); PG8_MMA(0, 0, At, B0); PG8_BAR; PG8_SCHED;
            PG8_LDB(B1, 0, 1); PG8_STAGE(PG8_SB(0, 0), b2, voffB);
            PG8_BAR; PG8_WAIT_L(0); PG8_MMA(0, 1, At, B1); PG8_BAR;
            PG8_LDA(At, 0, 1); PG8_STAGE(PG8_SA(0, 0), a2, voffA);
            PG8_BAR; PG8_WAIT_L(0); PG8_MMA(1, 0, At, B0); PG8_BAR; PG8_SCHED;
            PG8_STAGE(PG8_SB(0, 1), b2 + hstepB, voffB);
            PG8_WAIT_V(6); PG8_BAR; PG8_MMA(1, 1, At, B1); PG8_BAR;
            PG8_LDB(B0, 1, 0); PG8_SCHED; PG8_LDA(At, 1, 0); PG8_STAGE(PG8_SA(0, 1), a2 + hstepA, voffA);
            PG8_WAIT_L(8); PG8_BAR; PG8_WAIT_L(0); PG8_MMA(0, 0, At, B0); PG8_BAR; PG8_SCHED;
            PG8_LDB(B1, 1, 1); PG8_STAGE(PG8_SB(1, 0), b3, voffB);
            PG8_BAR; PG8_WAIT_L(0); PG8_MMA(0, 1, At, B1); PG8_BAR;
            PG8_LDA(At, 1, 1); PG8_STAGE(PG8_SA(1, 0), a3, voffA);
            PG8_BAR; PG8_WAIT_L(0); PG8_MMA(1, 0, At, B0); PG8_BAR; PG8_SCHED;
            PG8_STAGE(PG8_SB(1, 1), b3 + hstepB, voffB);
            PG8_WAIT_V(6); PG8_BAR; PG8_MMA(1, 1, At, B1); PG8_BAR;
        }
        E(acc, cur, wr, wc, fr, fq);
        if (!has_next) break;
#pragma unroll
        for (int a = 0; a < 2; ++a)
#pragma unroll
            for (int b = 0; b < 2; ++b)
#pragma unroll
                for (int m = 0; m < 4; ++m)
#pragma unroll
                    for (int n = 0; n < 2; ++n) acc[a][b][m][n] = (f32x4){0.f, 0.f, 0.f, 0.f};
        cur = nxt; cA = nA; cB = nB; ++ui;
    }
    PG8_WAIT_V(0);
    if (wr == 0) PG8_BAR;
    PG8_BAR;
#undef PG8_SA
#undef PG8_SB
#undef PG8_STAGE
#undef PG8_LDA
#undef PG8_LDB
#undef PG8_MMA
#undef PG8_WAIT_V
#undef PG8_WAIT_L
#undef PG8_BAR
#undef PG8_SCHED
}

struct EpiIn {
    static constexpr bool PERM = true, HAS_MID = false;
    bf16* ACT; bf16* XBC; float* DTR;
    __device__ __forceinline__ void operator()(const f32x4 (&acc)[2][2][4][2], const Unit& u, int wr, int wc, int fr, int fq) const {
        const int row0 = u.pm * BM + wr * 64 + fr;
        if (u.pn < 16) {
            bf16* base = ACT + (wc < 2 ? 0 : 1024) + 64 * u.pn + 32 * (wc & 1) + 8 * fq;
#pragma unroll
            for (int ai = 0; ai < 2; ++ai)
#pragma unroll
                for (int m = 0; m < 4; ++m) {
                    const f32x4 a0 = acc[ai][0][m][0], a1 = acc[ai][0][m][1], b0 = acc[ai][1][m][0], b1 = acc[ai][1][m][1];
                    f32x4 v0, v1;
                    if (wc < 2) { v0 = a0 * b0; v1 = a1 * b1; }
                    else {
#pragma unroll
                        for (int j = 0; j < 4; ++j) { v0[j] = a0[j] * silu_f(b0[j]); v1[j] = a1[j] * silu_f(b1[j]); }
                    }
                    u32x4 w; w.x = cvt_pk_bf16(v0[0], v0[1]); w.y = cvt_pk_bf16(v0[2], v0[3]); w.z = cvt_pk_bf16(v1[0], v1[1]); w.w = cvt_pk_bf16(v1[2], v1[3]);
                    *(u32x4*)(base + (size_t)(row0 + ai * HALF + m * 16) * LDACT) = w;
                }
        } else if (u.pn < 28) {
            bf16* base; int ld;
            if (u.pn < 20) { base = ACT + 2048 + (u.pn - 16) * 256 + 32 * wc + 8 * fq; ld = LDACT; }
            else { base = XBC + (u.pn - 20) * 256 + 32 * wc + 8 * fq; ld = DXBC; }
#pragma unroll
            for (int ai = 0; ai < 2; ++ai)
#pragma unroll
                for (int m = 0; m < 4; ++m) {
                    bf16* rowp = base + (size_t)(row0 + ai * HALF + m * 16) * ld;
#pragma unroll
                    for (int bj = 0; bj < 2; ++bj) {
                        const f32x4 v0 = acc[ai][bj][m][0], v1 = acc[ai][bj][m][1];
                        u32x4 w; w.x = cvt_pk_bf16(v0[0], v0[1]); w.y = cvt_pk_bf16(v0[2], v0[3]); w.z = cvt_pk_bf16(v1[0], v1[1]); w.w = cvt_pk_bf16(v1[2], v1[3]);
                        *(u32x4*)(rowp + bj * HALF) = w;
                    }
                }
        } else {
            if (wc == 0 && fq < 2) {
#pragma unroll
                for (int ai = 0; ai < 2; ++ai)
#pragma unroll
                    for (int m = 0; m < 4; ++m) {
                        float* p = DTR + (size_t)(row0 + ai * HALF + m * 16) * 16 + 8 * fq;
                        *(f32x4*)p = acc[ai][0][m][0]; *(f32x4*)(p + 4) = acc[ai][0][m][1];
                    }
            }
        }
    }
};

struct EpiOut {
    static constexpr bool PERM = true, HAS_MID = true;
    const float* MOD; const float* SS; bf16* DELTA; float* OUTS;
    __device__ __forceinline__ void mid(f32x4 (&acc)[2][2][4][2], const Unit& u, int wr, int fr) const {
        int rbase = u.pm * BM + wr * 64 + fr;
        asm volatile("" : "+v"(rbase));
#pragma unroll
        for (int ai = 0; ai < 2; ++ai)
#pragma unroll
            for (int m = 0; m < 4; ++m) {
                const int row = rbase + ai * HALF + m * 16;
                const f32x4 sa = *(const f32x4*)(SS + (size_t)row * 8), sb = *(const f32x4*)(SS + (size_t)row * 8 + 4);
                const float va = (sa[0] + sa[1]) + (sa[2] + sa[3]), vb = (sb[0] + sb[1]) + (sb[2] + sb[3]);
                const float tb = vb * (1.f / 1024.f) + EPS;
                const float ratio = rsqrtf(va * (1.f / 1024.f) + EPS) * (tb * rsqrtf(tb));
#pragma unroll
                for (int bj = 0; bj < 2; ++bj)
#pragma unroll
                    for (int n = 0; n < 2; ++n) acc[ai][bj][m][n] *= ratio;
                __builtin_amdgcn_sched_barrier(0);
            }
    }
    __device__ __forceinline__ void operator()(const f32x4 (&acc)[2][2][4][2], const Unit& u, int wr, int wc, int fr, int fq) const {
        const int col0 = u.pn * BM + wc * 32 + 8 * fq;
        if (u.nt != 32) {
#pragma unroll
            for (int ai = 0; ai < 2; ++ai)
#pragma unroll
                for (int m = 0; m < 4; ++m) {
                    const int row = u.pm * BM + ai * HALF + wr * 64 + m * 16 + fr;
                    const f32x4 sv = *(const f32x4*)(SS + (size_t)row * 8 + (u.k0 < 1024 ? 0 : 4));
                    const float rs = rsqrtf(((sv[0] + sv[1]) + (sv[2] + sv[3])) * (1.f / 1024.f) + EPS);
                    float* op = OUTS + ((size_t)(u.k0 >> 8) * MS + (row - MP)) * D + col0;
#pragma unroll
                    for (int bj = 0; bj < 2; ++bj)
#pragma unroll
                        for (int n = 0; n < 2; ++n) *(f32x4*)(op + bj * HALF + n * 4) = acc[ai][bj][m][n] * rs;
                }
            return;
        }
        const float* gp = MOD + (u.pm >> 6) * 3072 + 2048 + col0;
        f32x4 gv[2][2];
#pragma unroll
        for (int bj = 0; bj < 2; ++bj)
#pragma unroll
            for (int n = 0; n < 2; ++n) gv[bj][n] = *(const f32x4*)(gp + bj * HALF + n * 4);
#pragma unroll
        for (int ai = 0; ai < 2; ++ai)
#pragma unroll
            for (int m = 0; m < 4; ++m) {
                const int row = u.pm * BM + ai * HALF + wr * 64 + m * 16 + fr;
                const f32x4 sb = *(const f32x4*)(SS + (size_t)row * 8 + 4);
                const float rb = rsqrtf(((sb[0] + sb[1]) + (sb[2] + sb[3])) * (1.f / 1024.f) + EPS);
                bf16* op = DELTA + (size_t)row * D + col0;
#pragma unroll
                for (int bj = 0; bj < 2; ++bj) {
                    const f32x4 v0 = gv[bj][0] * (acc[ai][bj][m][0] * rb), v1 = gv[bj][1] * (acc[ai][bj][m][1] * rb);
                    u32x4 w; w.x = cvt_pk_bf16(v0[0], v0[1]); w.y = cvt_pk_bf16(v0[2], v0[3]); w.z = cvt_pk_bf16(v1[0], v1[1]); w.w = cvt_pk_bf16(v1[2], v1[3]);
                    *(u32x4*)(op + bj * HALF) = w;
                }
            }
    }
};
}

struct Args {
    const float* in[21]; float* out; unsigned char* ws; int pad0, pad1;
};
enum { I_XP = 0, I_XS, I_SCA, I_SCB, I_SSM, I_CP, I_CS, I_WMOD, I_BMOD, I_NIN, I_WIN, I_CAW, I_NAW, I_CBW, I_CBB, I_DTB, I_ALOG, I_DSKIP, I_NBW, I_WOUT, I_NFW };
constexpr size_t O_Y = 0, O_CAP = 34603008, O_CBP = 34607104, O_SSMP = 34619392, O_CAS = 34881536, O_CBS = 34914304, O_SSMS = 35012608, O_END = 37109760;

__device__ __forceinline__ int in_srccol(int n) {
    if (n < 4096) { const int w = n & 255, seg = w >> 6, j = (n >> 8) * 64 + (w & 63); const int off = seg == 0 ? 1024 : (seg == 1 ? 0 : (seg == 2 ? 2048 : 3072)); return off + j; }
    return n < NIN ? n : -1;
}
template <bool IN>
__device__ __forceinline__ void p0_transpose_item(const float* W, int K, int Nsrc, bf16* WT, LAS float* scr, int k0, int n0, int lane) {
    const int nd = n0 + (lane & 31); const int src = IN ? in_srccol(nd) : nd;
#pragma unroll
    for (int i = 0; i < 32; ++i) { const int kk = 2 * i + (lane >> 5); scr[kk * 33 + (lane & 31)] = src >= 0 ? W[(size_t)(k0 + kk) * Nsrc + src] : 0.f; }
    asm volatile("s_waitcnt lgkmcnt(0)" ::: "memory");
    const int c = lane & 7;
#pragma unroll
    for (int j = 0; j < 4; ++j) { const int n = (lane >> 3) + 8 * j; const LAS float* s = scr + (8 * c) * 33 + n;
        u32x4 o; o.x = cvt_pk_bf16(s[0 * 33], s[1 * 33]); o.y = cvt_pk_bf16(s[2 * 33], s[3 * 33]); o.z = cvt_pk_bf16(s[4 * 33], s[5 * 33]); o.w = cvt_pk_bf16(s[6 * 33], s[7 * 33]);
        *(u32x4*)(WT + (size_t)(n0 + n) * K + k0 + 8 * c) = o; }
    asm volatile("s_waitcnt lgkmcnt(0)" ::: "memory");
}

__device__ __forceinline__ void p0_prologue(const Args& a, LAS unsigned char* lds, int bid, int G) {
    int tid = threadIdx.x; asm volatile("" : "+v"(tid));

    for (int item = bid; item < 192; item += G) {
        LAS float* cl = (LAS float*)lds;
        LAS float* red = (LAS float*)(lds + 73728);
        for (int i = tid; i < NSEQ * 1024 / 4; i += NTHREADS) ((LAS f32x4*)cl)[i] = i < 512 ? ((const f32x4*)a.in[I_CP])[i] : ((const f32x4*)a.in[I_CS])[i - 512];
        const int col = tid & 15, kg = tid >> 4, j0 = item * 16;
        const float* wm = a.in[I_WMOD] + (size_t)(kg * 32) * 3072 + j0 + col;
        float w[32];
#pragma unroll
        for (int kk = 0; kk < 32; ++kk) w[kk] = wm[(size_t)kk * 3072];
        __syncthreads();
        float acc[NSEQ];
#pragma unroll
        for (int s = 0; s < NSEQ; ++s) acc[s] = 0.f;
#pragma unroll
        for (int k4 = 0; k4 < 8; ++k4) {
#pragma unroll
            for (int s = 0; s < NSEQ; ++s) { const f32x4 c4 = *(const LAS f32x4*)(cl + s * 1024 + kg * 32 + 4 * k4);
                acc[s] += (c4[0] * w[4 * k4] + c4[1] * w[4 * k4 + 1]) + (c4[2] * w[4 * k4 + 2] + c4[3] * w[4 * k4 + 3]); }
        }
#pragma unroll
        for (int s = 0; s < NSEQ; ++s) red[(kg * NSEQ + s) * 16 + col] = acc[s];
        __syncthreads();
        for (int o = tid; o < NSEQ * 16; o += NTHREADS) { const int s = o >> 4, c = o & 15; float v = a.in[I_BMOD][j0 + c];
#pragma unroll
            for (int k2 = 0; k2 < 32; ++k2) v += red[(k2 * NSEQ + s) * 16 + c];
            ((float*)(a.ws + WS_MOD))[s * 3072 + j0 + c] = v; }
        __syncthreads();
    }
}
__device__ __forceinline__ void p1_transposes(const Args& a, LAS unsigned char* lds, int bid, int G) {
    int tid = threadIdx.x; asm volatile("" : "+v"(tid));
    const int lane = tid & 63, wave = tid >> 6;
    LAS float* scr = (LAS float*)(lds + wave * 16384);
    const int gw = bid * 8 + wave, NGW = G * 8;
    constexpr int I_IN = (NINP / 32) * (D / 64), I_OUT = (D / 32) * (2048 / 64);
    for (int it = gw; it < I_IN + I_OUT; it += NGW) {
        if (it < I_IN) { const int nb = it / (D / 64), kb = it % (D / 64); p0_transpose_item<true>(a.in[I_WIN], D, NIN, (bf16*)(a.ws + WS_WTIN), scr, kb * 64, nb * 32, lane); }
        else { const int r = it - I_IN; const int nb = r / 32, kb = r % 32; p0_transpose_item<false>(a.in[I_WOUT], 2048, D, (bf16*)(a.ws + WS_WTOUT), scr, kb * 64, nb * 32, lane); }
    }
}

__device__ __forceinline__ void p1_norm(const Args& a, int bid, int G) {
    int tid = threadIdx.x; asm volatile("" : "+v"(tid));
    const int lane = tid & 63, wave = tid >> 6;
    const float* MOD = (const float*)(a.ws + WS_MOD); bf16* H = (bf16*)a.out;
    f32x4 nw[4];
#pragma unroll
    for (int j = 0; j < 4; ++j) nw[j] = ((const f32x4*)a.in[I_NIN])[lane + 64 * j];
    for (int row = bid * 8 + wave; row < MT; row += G * 8) {
        const f32x4* xr = (const f32x4*)(row < MP ? a.in[I_XP] + (size_t)row * D : a.in[I_XS] + (size_t)(row - MP) * D);
        const int s = seq_of_row(row);
        f32x4 v[4]; float ss = 0.f;
#pragma unroll
        for (int j = 0; j < 4; ++j) { v[j] = NT_LD(xr + lane + 64 * j); ss += (v[j][0] * v[j][0] + v[j][1] * v[j][1]) + (v[j][2] * v[j][2] + v[j][3] * v[j][3]); }
        const float rstd = rsqrtf(wave_sum(ss) * (1.f / D) + EPS);
        const f32x4* sh = (const f32x4*)(MOD + s * 3072); const f32x4* sc = (const f32x4*)(MOD + s * 3072 + 1024);
        u32x2* o = (u32x2*)(H + (size_t)row * D);
#pragma unroll
        for (int j = 0; j < 4; ++j) { const f32x4 h = v[j] * rstd * nw[j] * (sc[lane + 64 * j] + 1.f) + sh[lane + 64 * j];
            u32x2 w; w.x = cvt_pk_bf16(h[0], h[1]); w.y = cvt_pk_bf16(h[2], h[3]); o[lane + 64 * j] = w; }
    }
}

__device__ __forceinline__ u32x4 pack8(const float (&v)[8]) { u32x4 w; w.x = cvt_pk_bf16(v[0], v[1]); w.y = cvt_pk_bf16(v[2], v[3]); w.z = cvt_pk_bf16(v[4], v[5]); w.w = cvt_pk_bf16(v[6], v[7]); return w; }
__device__ __forceinline__ float rawel(const u32x4& w, int c) { const unsigned x = w[c >> 1]; return (c & 1) ? bfhi(x) : bflo(x); }
__device__ __forceinline__ void conv_load(const bf16* XBC, const float* stb, int cidx, int xcol, int rs, u32x4 (&r)[11]) {
    const bf16* p = XBC + (size_t)(cidx * 64 + 8 * rs - 3) * DXBC + xcol;
#pragma unroll
    for (int k = 3; k < 11; ++k) r[k] = *(const u32x4*)(p + (size_t)k * DXBC);
    if (rs > 0 || (cidx < 512 && (cidx & 255) != 0)) {
#pragma unroll
        for (int k = 0; k < 3; ++k) r[k] = *(const u32x4*)(p + (size_t)k * DXBC);
    } else if (cidx >= 512) {
        const float* s = stb + (size_t)(cidx - 512) * 3 * DXBC + xcol;
#pragma unroll
        for (int k = 0; k < 3; ++k) { const f32x4 a0 = *(const f32x4*)(s + k * DXBC), a1 = *(const f32x4*)(s + k * DXBC + 4);
            r[k].x = cvt_pk_bf16(a0[0], a0[1]); r[k].y = cvt_pk_bf16(a0[2], a0[3]); r[k].z = cvt_pk_bf16(a1[0], a1[1]); r[k].w = cvt_pk_bf16(a1[2], a1[3]); }
    } else {
#pragma unroll
        for (int k = 0; k < 3; ++k) r[k] = (u32x4){0u, 0u, 0u, 0u};
    }
}
struct ConvW { f32x4 w[4][2]; f32x4 b[2]; };
__device__ __forceinline__ void convw_load(const float* cw, const float* cb, int xcol, ConvW& W) {
#pragma unroll
    for (int j = 0; j < 4; ++j) { W.w[j][0] = *(const f32x4*)(cw + j * DXBC + xcol); W.w[j][1] = *(const f32x4*)(cw + j * DXBC + xcol + 4); }
    W.b[0] = *(const f32x4*)(cb + xcol); W.b[1] = *(const f32x4*)(cb + xcol + 4);
}
__device__ __forceinline__ float conv_el(const u32x4 (&r)[11], const ConvW& W, int t, int c) {
    const float v = W.b[c >> 2][c & 3] + W.w[0][c >> 2][c & 3] * rawel(r[t], c) + W.w[1][c >> 2][c & 3] * rawel(r[t + 1], c) + W.w[2][c >> 2][c & 3] * rawel(r[t + 2], c) + W.w[3][c >> 2][c & 3] * rawel(r[t + 3], c);
    return silu_f(v);
}
__device__ __forceinline__ float softplus_f(float x) { return x > 20.f ? x : log1pf(__expf(x)); }

#define WG_BAR() do { asm volatile("s_waitcnt lgkmcnt(0)" ::: "memory"); __builtin_amdgcn_s_barrier(); asm volatile("" ::: "memory"); } while (0)
__device__ __forceinline__ void p3_states(const Args& a, LAS unsigned char* lds, int bid, int G) {
    int tid = threadIdx.x; asm volatile("" : "+v"(tid));
    const int lane = tid & 63, wave = __builtin_amdgcn_readfirstlane(tid >> 6), fr = lane & 15, fq = lane >> 4;
    const bf16* XBC = (const bf16*)(a.ws + WS_XBC); const float* DTR = (const float*)(a.ws + WS_DTR);
    float* DTV = (float*)(a.ws + WS_DTV); float* ACU = (float*)(a.ws + WS_ACU); float* CD = (float*)(a.ws + WS_CD);
    bf16* ST = (bf16*)(a.ws + WS_ST);
    LAS float* dtw2 = (LAS float*)lds; LAS float* cdl2 = (LAS float*)(lds + 2048);
    LAS bf16* xsT = (LAS bf16*)(lds + 4096); LAS bf16* BT = (LAS bf16*)(lds + 40960);
    bf16* XSI = (bf16*)a.out; bf16* BNI = (bf16*)((unsigned char*)a.out + BNI_OFF);
    const int rs = lane & 7, cg = 8 * wave + (lane >> 3);
    bf16* RA = (bf16*)((unsigned char*)a.out + RA_OFF); float* RD = (float*)(a.ws + WS_RD); float* CDP = (float*)(a.ws + WS_CDP);
#define P3_DT(CIDX, GG, BUF, DTRAW) do { if (wave < 4) { const int cidx_ = (CIDX), h_ = 4 * (GG) + wave, row_ = cidx_ * 64 + lane; \
        const float dt = softplus_f((DTRAW) + a.in[I_DTB][h_]); const float da = dt * -__expf(a.in[I_ALOG][h_]); float ac = da; \
        _Pragma("unroll") for (int o = 1; o < 64; o <<= 1) { const float t = __shfl_up(ac, o); if (lane >= o) ac += t; } \
        const float tot = __shfl(ac, 63); \
        dtw2[(BUF) * 256 + lane * 4 + wave] = dt * __expf(tot - ac); \
        DTV[(size_t)row_ * 16 + h_] = dt; ACU[(size_t)row_ * 16 + h_] = ac; \
        if (lane == 63) { const float cdv = __expf(tot); CD[cidx_ * 16 + h_] = cdv; cdl2[(BUF) * 4 + wave] = cdv; } } } while (0)
    for (int rho = bid; rho < NRUN + 64; rho += G) {
      const bool samp = rho >= NRUN;
      const int g = samp ? ((rho - NRUN) & 3) : ((rho >> 5) & 3);
      const int cbase = samp ? 512 + ((rho - NRUN) >> 2) : (rho >> 7) * 256 + (rho & 31) * 8;
      const int nci = samp ? 1 : 8;
      f32x4 acc[4][4];
#pragma unroll
      for (int i = 0; i < 4; ++i)
#pragma unroll
          for (int j = 0; j < 4; ++j) acc[i][j] = (f32x4){0.f, 0.f, 0.f, 0.f};
      float cum = 1.f;
      LAS float* cwl = (LAS float*)(lds + 59392);
      for (int i = tid; i < 5 * 384; i += NTHREADS) { const int j = i / 384, col = i - j * 384; const int xc = col < 256 ? 256 * g + col : 1024 + 128 * g + (col - 256);
          cwl[i] = j < 4 ? a.in[I_CBW][j * DXBC + xc] : a.in[I_CBB][xc]; }
      { const float d0 = DTR[(size_t)(cbase * 64 + lane) * 16 + 4 * g + (wave & 3)]; P3_DT(cbase, g, 0, d0); }
      __syncthreads();
#pragma unroll 1
      for (int ci = 0; ci < nci; ++ci) {
        const int cidx = cbase + ci, unit = cidx * 4 + g, row0 = cidx * 64;
        u32x4 r[11];
        const int xcol = cg < 32 ? 256 * g + 8 * cg : 1024 + 128 * g + 8 * (cg - 32);
        if (wave < 6) conv_load(XBC, a.in[I_SCB], cidx, xcol, rs, r);
        const int pb = ci & 1;
        const float dnext = DTR[(size_t)((ci + 1 < nci ? cidx + 1 : cidx) * 64 + lane) * 16 + 4 * g + (wave & 3)];
        if (wave < 6 && rs == 7 && (cidx >= 512 || (cidx & 255) == 255)) {
            float* op = cidx >= 512 ? a.out + O_CBS + (size_t)(cidx - 512) * 3 * DXBC + xcol : a.out + O_CBP + (size_t)(cidx >> 8) * 3 * DXBC + xcol;
#pragma unroll
            for (int k = 0; k < 3; ++k) { *(f32x4*)(op + k * DXBC) = (f32x4){rawel(r[8 + k], 0), rawel(r[8 + k], 1), rawel(r[8 + k], 2), rawel(r[8 + k], 3)};
                *(f32x4*)(op + k * DXBC + 4) = (f32x4){rawel(r[8 + k], 4), rawel(r[8 + k], 5), rawel(r[8 + k], 6), rawel(r[8 + k], 7)}; }
        }
        if (wave < 4) {
            LAS bf16* dst = xsT + (8 * cg) * 72 + 8 * rs;
            bf16* gi = XSI + (size_t)unit * XSI_UNIT + (8 * cg) * 72 + 8 * rs;
            float sc[8];
#pragma unroll
            for (int t = 0; t < 8; ++t) sc[t] = dtw2[pb * 256 + (8 * rs + t) * 4 + wave];
#pragma unroll
            for (int c = 0; c < 8; ++c) {
                float o[8]; const LAS float* wp = cwl + 8 * cg + c;
                const float w0 = wp[0], w1 = wp[384], w2 = wp[768], w3 = wp[1152], wb = wp[1536];
#pragma unroll
                for (int t = 0; t < 8; ++t) o[t] = silu_f(wb + w0 * rawel(r[t], c) + w1 * rawel(r[t + 1], c) + w2 * rawel(r[t + 2], c) + w3 * rawel(r[t + 3], c));
                *(u32x4*)(gi + c * 72) = pack8(o);
#pragma unroll
                for (int t = 0; t < 8; ++t) o[t] *= sc[t];
                *(LAS u32x4*)(dst + c * 72) = pack8(o);
            }
        } else if (wave < 6) {
            LAS bf16* dst = BT + (8 * (cg - 32)) * 72 + 8 * rs;
            bf16* gi = BNI + (size_t)unit * BNI_UNIT + (8 * rs) * 136 + 8 * (cg - 32);
            u32x4 rowpk[8];
#pragma unroll
            for (int c2 = 0; c2 < 4; ++c2) {
                float o0[8], o1[8]; const LAS float* wp = cwl + 8 * cg + 2 * c2;
                const float w0 = wp[0], w1 = wp[384], w2 = wp[768], w3 = wp[1152], wb = wp[1536], v0 = wp[1], v1 = wp[385], v2 = wp[769], v3 = wp[1153], vb = wp[1537];
#pragma unroll
                for (int t = 0; t < 8; ++t) { o0[t] = silu_f(wb + w0 * rawel(r[t], 2 * c2) + w1 * rawel(r[t + 1], 2 * c2) + w2 * rawel(r[t + 2], 2 * c2) + w3 * rawel(r[t + 3], 2 * c2));
                    o1[t] = silu_f(vb + v0 * rawel(r[t], 2 * c2 + 1) + v1 * rawel(r[t + 1], 2 * c2 + 1) + v2 * rawel(r[t + 2], 2 * c2 + 1) + v3 * rawel(r[t + 3], 2 * c2 + 1)); }
                *(LAS u32x4*)(dst + (2 * c2) * 72) = pack8(o0); *(LAS u32x4*)(dst + (2 * c2 + 1) * 72) = pack8(o1);
#pragma unroll
                for (int t = 0; t < 8; ++t) rowpk[t][c2] = cvt_pk_bf16(o0[t], o1[t]);
            }
#pragma unroll
            for (int t = 0; t < 8; ++t) *(u32x4*)(gi + t * 136) = rowpk[t];
        }
        __syncthreads();
        {
            const int hl = wave >> 1, nh = wave & 1, h = 4 * g + hl;
            const float cdv = cdl2[pb * 4 + hl];
            if (!samp) {
                if (ci > 0) {
                bf16* sp = ST + ((size_t)cidx * 16 + h) * 8192;
#pragma unroll
                for (int i = 0; i < 4; ++i)
#pragma unroll
                    for (int j = 0; j < 4; ++j) { u32x2 w; w.x = cvt_pk_bf16(acc[i][j][0], acc[i][j][1]); w.y = cvt_pk_bf16(acc[i][j][2], acc[i][j][3]);
                        *(u32x2*)(sp + (16 * j + fr) * 128 + 64 * nh + 16 * i + 4 * fq) = w; }
                }
                if (nh == 0 && lane == 0) CDP[cidx * 16 + h] = cum;
#pragma unroll
                for (int i = 0; i < 4; ++i)
#pragma unroll
                    for (int j = 0; j < 4; ++j) acc[i][j] *= cdv;
                cum *= cdv;
            }
#pragma unroll
            for (int ks = 0; ks < 2; ++ks) {
                bf16x8 xf[4], yf[4];
#pragma unroll
                for (int i = 0; i < 4; ++i) xf[i] = *(const LAS bf16x8*)(BT + (64 * nh + 16 * i + fr) * 72 + 32 * ks + 8 * fq);
#pragma unroll
                for (int j = 0; j < 4; ++j) yf[j] = *(const LAS bf16x8*)(xsT + (64 * hl + 16 * j + fr) * 72 + 32 * ks + 8 * fq);
#pragma unroll
                for (int i = 0; i < 4; ++i)
#pragma unroll
                    for (int j = 0; j < 4; ++j) acc[i][j] = __builtin_amdgcn_mfma_f32_16x16x32_bf16(xf[i], yf[j], acc[i][j], 0, 0, 0);
            }
            if (samp) {
                const int b = cidx - 512;
                const float* s0 = a.in[I_SSM] + ((size_t)b * 16 + h) * 8192; float* so = a.out + O_SSMS + ((size_t)b * 16 + h) * 8192;
#pragma unroll
                for (int i = 0; i < 4; ++i)
#pragma unroll
                    for (int j = 0; j < 4; ++j) { const int off = (16 * j + fr) * 128 + 64 * nh + 16 * i + 4 * fq;
                        *(f32x4*)(so + off) = *(const f32x4*)(s0 + off) * cdv + acc[i][j]; }
            }
        }
        if (ci + 1 < nci) P3_DT(cidx + 1, g, pb ^ 1, dnext);
        __syncthreads();
      }
      if (!samp) {
          const int hl = wave >> 1, nh = wave & 1;
          bf16* sp = RA + ((size_t)rho * 4 + hl) * 8192;
#pragma unroll
          for (int i = 0; i < 4; ++i)
#pragma unroll
              for (int j = 0; j < 4; ++j) { u32x2 w; w.x = cvt_pk_bf16(acc[i][j][0], acc[i][j][1]); w.y = cvt_pk_bf16(acc[i][j][2], acc[i][j][3]);
                  *(u32x2*)(sp + (16 * j + fr) * 128 + 64 * nh + 16 * i + 4 * fq) = w; }
          if (nh == 0 && lane == 0) RD[rho * 4 + hl] = cum;
      }
    }
}

__device__ __forceinline__ void p4_scan(const Args& a, int bid, int G) {
    unsigned* RAw = (unsigned*)((unsigned char*)a.out + RA_OFF); const float* RD = (const float*)(a.ws + WS_RD);
    for (int idx = bid * NTHREADS + (int)threadIdx.x; idx < 8 * 16384; idx += G * NTHREADS) {
        const int sg = idx >> 14, e2 = idx & 16383, hl = e2 >> 12;
        float run0 = 0.f, run1 = 0.f;
        unsigned* p = RAw + (size_t)(sg * 32) * 16384 + e2; const float* rd = RD + (sg * 32) * 4 + hl;
        unsigned v[32]; float d[32];
#pragma unroll
        for (int k = 0; k < 32; ++k) { v[k] = p[(size_t)k * 16384]; d[k] = rd[k * 4]; }
#pragma unroll
        for (int k = 0; k < 32; ++k) { p[(size_t)k * 16384] = cvt_pk_bf16(run0, run1); run0 = run0 * d[k] + bflo(v[k]); run1 = run1 * d[k] + bfhi(v[k]); }
        *(f32x2*)(a.out + O_SSMP + (size_t)(sg >> 2) * 131072 + (size_t)(4 * (sg & 3) + hl) * 8192 + 2 * (e2 & 4095)) = (f32x2){run0, run1};
    }
}

__device__ __forceinline__ void p5_mix(const Args& a, LAS unsigned char* lds, int bid, int G) {
    int tid = threadIdx.x; asm volatile("" : "+v"(tid));
    const int lane = tid & 63, wave = __builtin_amdgcn_readfirstlane(tid >> 6), fr = lane & 15, fq = lane >> 4;
    bf16* ACT = (bf16*)(a.ws + WS_ACT); const bf16* XBC = (const bf16*)(a.ws + WS_XBC);
    const float* DTV = (const float*)(a.ws + WS_DTV); const float* ACU = (const float*)(a.ws + WS_ACU);
    const bf16* ST = (const bf16*)(a.ws + WS_ST); float* SS = (float*)(a.ws + WS_SS);
    LAS float* dtv = (LAS float*)lds; LAS float* acu = (LAS float*)(lds + 1024); LAS float* ea = (LAS float*)(lds + 2048);
    LAS float* partA = (LAS float*)(lds + 3072); LAS float* partB = (LAS float*)(lds + 3584);
    LAS bf16* xsT = (LAS bf16*)(lds + 8192); LAS bf16* Bn = (LAS bf16*)(lds + 45056); LAS bf16* Cn = (LAS bf16*)(lds + 62464); LAS bf16* Mh = (LAS bf16*)(lds + 79872);
    const bf16* XSI = (const bf16*)a.out; const bf16* BNI = (const bf16*)((const unsigned char*)a.out + BNI_OFF);
    const int tidp5_ = tid; const int cgc = tid & 15, rs2 = tid >> 4;
    u32x4 im[7], rc[5]; ConvW W; float dt_r, ac_r;
#define P5_LOADS(UNIT) do { const int u_ = (UNIT), cidx_ = u_ >> 2, q_ = u_ & 3; int tid = tidp5_; asm volatile("" : "+v"(tid));   \
        const int cgc = tid & 15, rs2 = tid >> 4, xcol_ = 1536 + 128 * q_ + 8 * cgc; \
        dt_r = DTV[(size_t)(cidx_ * 64 + ((tid & 255) >> 2)) * 16 + 4 * q_ + (tid & 3)]; ac_r = ACU[(size_t)(cidx_ * 64 + ((tid & 255) >> 2)) * 16 + 4 * q_ + (tid & 3)]; \
        const bool sample_ = cidx_ >= 512, first_ = !sample_ && (cidx_ & 255) == 0; \
        const u32x4* xi_ = (const u32x4*)(XSI + (size_t)u_ * XSI_UNIT); const u32x4* bi_ = (const u32x4*)(BNI + (size_t)u_ * BNI_UNIT); \
        _Pragma("unroll") for (int k = 0; k < 7; ++k) { const int idx = tid + NTHREADS * k; if (idx < 2304) im[k] = xi_[idx]; else if (idx < 3392) im[k] = bi_[idx - 2304]; } \
        const int tb_ = 2 * rs2 - 3; \
        _Pragma("unroll") for (int k = 0; k < 5; ++k) { const int tr = tb_ + k; \
            if (tr >= 0 || (!sample_ && !first_)) rc[k] = *(const u32x4*)(XBC + (size_t)(cidx_ * 64 + tr) * DXBC + xcol_); \
            else if (sample_) { const float* sp = a.in[I_SCB] + ((size_t)(cidx_ - 512) * 3 + (3 + tr)) * DXBC + xcol_; const f32x4 a0 = *(const f32x4*)sp, a1 = *(const f32x4*)(sp + 4); \
                rc[k].x = cvt_pk_bf16(a0[0], a0[1]); rc[k].y = cvt_pk_bf16(a0[2], a0[3]); rc[k].z = cvt_pk_bf16(a1[0], a1[1]); rc[k].w = cvt_pk_bf16(a1[2], a1[3]); } \
            else rc[k] = (u32x4){0u, 0u, 0u, 0u}; } \
        convw_load(a.in[I_CBW], a.in[I_CBB], xcol_, W); } while (0)
    if (bid < NCHUNK * 4) P5_LOADS(bid);
    for (int unit = bid; unit < NCHUNK * 4; unit += G) {
        const int cidx = unit >> 2, q = unit & 3, row0 = cidx * 64;
        const bool sample = cidx >= 512, first = !sample && (cidx & 255) == 0, lastc = sample || (cidx & 255) == 255;
        const int xcol = 1536 + 128 * q + 8 * cgc;
        if (tid < 256) { dtv[tid] = dt_r; acu[tid] = ac_r; ea[tid] = __expf(ac_r); }
#pragma unroll
        for (int k = 0; k < 7; ++k) { const int idx = tid + NTHREADS * k; if (idx < 2304) ((LAS u32x4*)xsT)[idx] = im[k]; else if (idx < 3392) ((LAS u32x4*)Bn)[idx - 2304] = im[k]; }
        if (lastc && rs2 == 31) {
            float* op = sample ? a.out + O_CBS + (size_t)(cidx - 512) * 3 * DXBC + xcol : a.out + O_CBP + (size_t)(cidx >> 8) * 3 * DXBC + xcol;
#pragma unroll
            for (int k = 0; k < 3; ++k) { *(f32x4*)(op + k * DXBC) = (f32x4){rawel(rc[2 + k], 0), rawel(rc[2 + k], 1), rawel(rc[2 + k], 2), rawel(rc[2 + k], 3)};
                *(f32x4*)(op + k * DXBC + 4) = (f32x4){rawel(rc[2 + k], 4), rawel(rc[2 + k], 5), rawel(rc[2 + k], 6), rawel(rc[2 + k], 7)}; }
        }
#pragma unroll
        for (int t = 0; t < 2; ++t) {
            float o[8];
#pragma unroll
            for (int c = 0; c < 8; ++c) {
                const float v = W.b[c >> 2][c & 3] + W.w[0][c >> 2][c & 3] * rawel(rc[t], c) + W.w[1][c >> 2][c & 3] * rawel(rc[t + 1], c) + W.w[2][c >> 2][c & 3] * rawel(rc[t + 2], c) + W.w[3][c >> 2][c & 3] * rawel(rc[t + 3], c);
                o[c] = silu_f(v);
            }
            *(LAS u32x4*)(Cn + (2 * rs2 + t) * 136 + 8 * cgc) = pack8(o);
        }
        WG_BAR();
        {
#pragma unroll 1
            for (int tt = 0; tt < 2; ++tt) {
                const int tile = wave * 2 + tt, it = tile >> 2, jt = tile & 3;
                if (jt > it) {
#pragma unroll
                    for (int hl = 0; hl < 4; ++hl) *(LAS u32x2*)(Mh + (hl * 64 + 16 * it + fr) * 72 + 16 * jt + 4 * fq) = (u32x2){0u, 0u};
                    continue;
                }
                f32x4 cb = (f32x4){0.f, 0.f, 0.f, 0.f};
#pragma unroll
                for (int ks = 0; ks < 4; ++ks) {
                    const bf16x8 xf = *(const LAS bf16x8*)(Bn + (16 * jt + fr) * 136 + 32 * ks + 8 * fq);
                    const bf16x8 yf = *(const LAS bf16x8*)(Cn + (16 * it + fr) * 136 + 32 * ks + 8 * fq);
                    cb = __builtin_amdgcn_mfma_f32_16x16x32_bf16(xf, yf, cb, 0, 0, 0);
                }
                const int i = 16 * it + fr, jb = 16 * jt + 4 * fq;
#pragma unroll
                for (int hl = 0; hl < 4; ++hl) {
                    const float ai = acu[i * 4 + hl], dsk = a.in[I_DSKIP][4 * q + hl];
                    float mv[4];
#pragma unroll
                    for (int jj = 0; jj < 4; ++jj) { const int j = jb + jj;
                        float v = (i >= j) ? cb[jj] * __expf(ai - acu[j * 4 + hl]) * dtv[j * 4 + hl] : 0.f;
                        if (i == j) v += dsk;
                        mv[jj] = v; }
                    u32x2 w; w.x = cvt_pk_bf16(mv[0], mv[1]); w.y = cvt_pk_bf16(mv[2], mv[3]);
                    *(LAS u32x2*)(Mh + (hl * 64 + i) * 72 + jb) = w;
                }
            }
        }
        WG_BAR();
            const int ca = lane & 31, ra = 2 * wave + (lane >> 5), ja = 256 * q + 8 * ca, ta = 4 * ra;
            u32x4 ur[6], br[4];
        {
            const int hl = wave >> 1, ph = wave & 1, h = 4 * q + hl;
            float ssqa[4] = {0.f, 0.f, 0.f, 0.f};
            const bool haslp = sample || (cidx & 7) != 0;
#pragma unroll 1
            for (int ptl = 0; ptl < 2; ++ptl) {
                const int p0 = 32 * ph + 16 * ptl;
                bf16x8 sf[4], lf[4]; float cdp = 0.f;
                if (!sample) {
                    const int rho = ((cidx >> 8) * 4 + q) * 32 + ((cidx & 255) >> 3);
                    const bf16* sr = (const bf16*)((const unsigned char*)a.out + RA_OFF) + ((size_t)rho * 4 + hl) * 8192 + (p0 + fr) * 128 + 8 * fq;
                    const bf16* sp = ST + ((size_t)cidx * 16 + h) * 8192 + (p0 + fr) * 128 + 8 * fq;
#pragma unroll
                    for (int ks = 0; ks < 4; ++ks) { sf[ks] = *(const bf16x8*)(sr + 32 * ks); if (haslp) lf[ks] = *(const bf16x8*)(sp + 32 * ks); }
                    cdp = ((const float*)(a.ws + WS_CDP))[cidx * 16 + h];
                } else {
                    const float* sp = a.in[I_SSM] + ((size_t)(cidx - 512) * 16 + h) * 8192 + (p0 + fr) * 128 + 8 * fq;
#pragma unroll
                    for (int ks = 0; ks < 4; ++ks) { const f32x4 v0 = *(const f32x4*)(sp + 32 * ks), v1 = *(const f32x4*)(sp + 32 * ks + 4);
                        u32x4 w; w.x = cvt_pk_bf16(v0[0], v0[1]); w.y = cvt_pk_bf16(v0[2], v0[3]); w.z = cvt_pk_bf16(v1[0], v1[1]); w.w = cvt_pk_bf16(v1[2], v1[3]);
                        lf[ks] = __builtin_bit_cast(bf16x8, w); }
                }
                bf16* zp0 = ACT + (size_t)(row0 + fr) * LDACT + 2048 + 256 * q + 64 * hl + p0 + 4 * fq;
                u32x2 zw[4];
#pragma unroll
                for (int il = 0; il < 4; ++il) zw[il] = *(const u32x2*)(zp0 + (size_t)(16 * il) * LDACT);
                const f32x4 nw4 = *(const f32x4*)(a.in[I_NBW] + 256 * q + 64 * hl + p0 + 4 * fq);
                f32x4 ad[4], ao[4];
#pragma unroll
                for (int il = 0; il < 4; ++il) { ad[il] = (f32x4){0.f, 0.f, 0.f, 0.f}; ao[il] = (f32x4){0.f, 0.f, 0.f, 0.f}; }
#pragma unroll
                for (int ks = 0; ks < 2; ++ks) {
                    const bf16x8 xf = *(const LAS bf16x8*)(xsT + (64 * hl + p0 + fr) * 72 + 32 * ks + 8 * fq);
#pragma unroll
                    for (int il = 0; il < 4; ++il) ad[il] = __builtin_amdgcn_mfma_f32_16x16x32_bf16(xf, *(const LAS bf16x8*)(Mh + (hl * 64 + 16 * il + fr) * 72 + 32 * ks + 8 * fq), ad[il], 0, 0, 0);
                }
                if (!sample) {
#pragma unroll
                    for (int ks = 0; ks < 4; ++ks)
#pragma unroll
                        for (int il = 0; il < 4; ++il) ao[il] = __builtin_amdgcn_mfma_f32_16x16x32_bf16(sf[ks], *(const LAS bf16x8*)(Cn + (16 * il + fr) * 136 + 32 * ks + 8 * fq), ao[il], 0, 0, 0);
#pragma unroll
                    for (int il = 0; il < 4; ++il) ao[il] *= cdp;
                }
                if (haslp) {
#pragma unroll
                for (int ks = 0; ks < 4; ++ks)
#pragma unroll
                    for (int il = 0; il < 4; ++il) ao[il] = __builtin_amdgcn_mfma_f32_16x16x32_bf16(lf[ks], *(const LAS bf16x8*)(Cn + (16 * il + fr) * 136 + 32 * ks + 8 * fq), ao[il], 0, 0, 0);
                }
#pragma unroll
                for (int il = 0; il < 4; ++il) {
                    const float eai = ea[(16 * il + fr) * 4 + hl];
                    const u32x2 zv = zw[il];
                    const f32x4 y = ad[il] + ao[il] * eai;
                    const float g0 = y[0] * silu_f(bflo(zv.x)), g1 = y[1] * silu_f(bfhi(zv.x)), g2 = y[2] * silu_f(bflo(zv.y)), g3 = y[3] * silu_f(bfhi(zv.y));
                    ssqa[il] += (g0 * g0 + g1 * g1) + (g2 * g2 + g3 * g3);
                    u32x2 w; w.x = cvt_pk_bf16(g0 * nw4[0], g1 * nw4[1]); w.y = cvt_pk_bf16(g2 * nw4[2], g3 * nw4[3]);
                    *(u32x2*)(zp0 + (size_t)(16 * il) * LDACT) = w;
                }
            }
#pragma unroll
            for (int il = 0; il < 4; ++il) { float ssq = ssqa[il]; ssq += __shfl_xor(ssq, 16); ssq += __shfl_xor(ssq, 32); if (fq == 0) partB[wave * 64 + 16 * il + fr] = ssq; }
            __builtin_amdgcn_sched_barrier(0);
#pragma unroll
            for (int k = 0; k < 4; ++k) { ur[k + 2] = *(const u32x4*)(ACT + (size_t)(row0 + ta + k) * LDACT + ja); br[k] = *(const u32x4*)(ACT + (size_t)(row0 + ta + k) * LDACT + 1024 + ja); }
            if (ra > 0 || (!sample && !first)) {
#pragma unroll
                for (int k = 0; k < 2; ++k) ur[k] = *(const u32x4*)(ACT + (size_t)(row0 + ta - 2 + k) * LDACT + ja);
            } else if (sample) {
                const float* p = a.in[I_SCA] + (size_t)(cidx - 512) * 2 * D + ja;
#pragma unroll
                for (int k = 0; k < 2; ++k) { const f32x4 x0 = *(const f32x4*)(p + k * D), x1 = *(const f32x4*)(p + k * D + 4);
                    ur[k].x = cvt_pk_bf16(x0[0], x0[1]); ur[k].y = cvt_pk_bf16(x0[2], x0[3]); ur[k].z = cvt_pk_bf16(x1[0], x1[1]); ur[k].w = cvt_pk_bf16(x1[2], x1[3]); }
            } else { ur[0] = (u32x4){0u, 0u, 0u, 0u}; ur[1] = ur[0]; }

        }
        {
            const float* caw = a.in[I_CAW];
            f32x4 w0[2], w1[2], w2[2], nw[2];
#pragma unroll
            for (int hh = 0; hh < 2; ++hh) { w0[hh] = *(const f32x4*)(caw + ja + 4 * hh); w1[hh] = *(const f32x4*)(caw + D + ja + 4 * hh); w2[hh] = *(const f32x4*)(caw + 2 * D + ja + 4 * hh); nw[hh] = *(const f32x4*)(a.in[I_NAW] + ja + 4 * hh); }
#pragma unroll
            for (int k = 0; k < 4; ++k) {
                float y[8], ssq = 0.f;
#pragma unroll
                for (int c = 0; c < 8; ++c) {
                    const float v = rawel(br[k], c) * (w0[c >> 2][c & 3] * rawel(ur[k], c) + w1[c >> 2][c & 3] * rawel(ur[k + 1], c) + w2[c >> 2][c & 3] * rawel(ur[k + 2], c));
                    ssq += v * v; y[c] = v * nw[c >> 2][c & 3];
                }
                *(u32x4*)(ACT + (size_t)(row0 + ta + k) * LDACT + 1024 + ja) = pack8(y);
#pragma unroll
                for (int o = 1; o < 32; o <<= 1) ssq += __shfl_xor(ssq, o);
                if (ca == 0) partA[ta + k] = ssq;
            }
            if (lastc && ra == 15) {
                float* o = sample ? a.out + O_CAS + (size_t)(cidx - 512) * 2 * D + ja : a.out + O_CAP + (size_t)(cidx >> 8) * 2 * D + ja;
#pragma unroll
                for (int k = 0; k < 2; ++k) { *(f32x4*)(o + k * D) = (f32x4){rawel(ur[4 + k], 0), rawel(ur[4 + k], 1), rawel(ur[4 + k], 2), rawel(ur[4 + k], 3)};
                    *(f32x4*)(o + k * D + 4) = (f32x4){rawel(ur[4 + k], 4), rawel(ur[4 + k], 5), rawel(ur[4 + k], 6), rawel(ur[4 + k], 7)}; }
            }
        }
        __builtin_amdgcn_sched_barrier(0);
        __builtin_amdgcn_sched_barrier(0);
        P5_LOADS(unit + G < NCHUNK * 4 ? unit + G : unit);
        WG_BAR();
        if (tid < 64) { SS[(size_t)(row0 + tid) * 8 + q] = partA[tid];
            SS[(size_t)(row0 + tid) * 8 + 4 + q] = ((partB[tid] + partB[64 + tid]) + (partB[128 + tid] + partB[192 + tid])) + ((partB[256 + tid] + partB[320 + tid]) + (partB[384 + tid] + partB[448 + tid])); }
    }
}

__device__ __forceinline__ void p7_final(const Args& a, int bid, int G) {
    int tid = threadIdx.x; asm volatile("" : "+v"(tid));
    const int lane = tid & 63, wave = tid >> 6;
    f32x4 nw[4];
#pragma unroll
    for (int j = 0; j < 4; ++j) nw[j] = ((const f32x4*)a.in[I_NFW])[lane + 64 * j];
    for (int row = bid * 8 + wave; row < MT; row += G * 8) {
        f32x4* yr = (f32x4*)(a.out + (size_t)row * D);
        f32x4 v[4]; float ss = 0.f;
        if (row < MP) {
            const f32x4* xi = (const f32x4*)(a.in[I_XP] + (size_t)row * D); const u32x2* dl = (const u32x2*)((const bf16*)(a.ws + WS_DELTA) + (size_t)row * D);
#pragma unroll
            for (int j = 0; j < 4; ++j) { const u32x2 d = dl[lane + 64 * j]; v[j] = NT_LD(xi + lane + 64 * j) + (f32x4){bflo(d.x), bfhi(d.x), bflo(d.y), bfhi(d.y)}; }
        } else {
            const f32x4* xi = (const f32x4*)(a.in[I_XS] + (size_t)(row - MP) * D); const f32x4* os = (const f32x4*)(a.ws + WS_OUTS) + (size_t)(row - MP) * (D / 4);
            const f32x4* gp = (const f32x4*)((const float*)(a.ws + WS_MOD) + seq_of_row(row) * 3072 + 2048);
#pragma unroll
            for (int j = 0; j < 4; ++j) { f32x4 o = os[lane + 64 * j];
#pragma unroll
                for (int sl = 1; sl < 8; ++sl) o += os[(size_t)sl * MS * (D / 4) + lane + 64 * j];
                v[j] = xi[lane + 64 * j] + gp[lane + 64 * j] * o; }
        }
#pragma unroll
        for (int j = 0; j < 4; ++j) ss += (v[j][0] * v[j][0] + v[j][1] * v[j][1]) + (v[j][2] * v[j][2] + v[j][3] * v[j][3]);
        const float rstd = rsqrtf(wave_sum(ss) * (1.f / D) + EPS);
#pragma unroll
        for (int j = 0; j < 4; ++j) NT_ST(yr + lane + 64 * j, v[j] * rstd * nw[j]);
    }
}

#define XB_TMO      128
#define XB_XCNT(j)  (256  + 64 * (j))
#define XB_XSUB(j)  (1280 + 64 * (j))
#define XB_XGEN(j)  (2304 + 64 * (j))
#define XB_TOP      3328
#define XB_TOPGEN   3392
#define XCD_BAR_WORDS 3456
#define XB_SPIN_CAP (1u << 18)
__device__ __forceinline__ unsigned xb_ld(unsigned* p)              { return __hip_atomic_load(p, __ATOMIC_RELAXED, __HIP_MEMORY_SCOPE_AGENT); }
__device__ __forceinline__ unsigned xb_add(unsigned* p, unsigned v) { return __hip_atomic_fetch_add(p, v, __ATOMIC_RELAXED, __HIP_MEMORY_SCOPE_AGENT); }
__device__ __forceinline__ unsigned xb_xcc_id() { return (unsigned)__builtin_amdgcn_s_getreg((3 << 11) | 20) & 0xFu; }
#define XB_SPIN(cond, bar) do { unsigned _sp = 0; while (cond) { __builtin_amdgcn_s_sleep(1); \
    if ((++_sp & 255u) == 0u) { if (xb_ld(&(bar)[XB_TMO])) break; if (_sp > XB_SPIN_CAP) { atomicAdd(&(bar)[XB_TMO], 1u); break; } } } } while (0)
struct XcdBarrier { unsigned* bar; unsigned x; volatile LAS unsigned* st; };
__device__ __forceinline__ XcdBarrier xcd_barrier_post(unsigned* bar, volatile LAS unsigned* st) {
    XcdBarrier b; b.bar = bar; b.x = xb_xcc_id(); b.st = st;
    if (threadIdx.x == 0) (void)xb_add(&bar[XB_XCNT(b.x)], 1u);
    return b;
}
__device__ __forceinline__ void xcd_barrier_complete(unsigned* bar, unsigned x, unsigned& nloc, unsigned& nx) {
    const unsigned G = gridDim.x * gridDim.y * gridDim.z;
    unsigned sum, cnt, mine, sp = 0u;
    for (;;) {
        sum = 0u; cnt = 0u; mine = 0u;
#pragma unroll
        for (unsigned j = 0; j < 16; ++j) { const unsigned c = xb_ld(&bar[XB_XCNT(j)]); sum += c; cnt += (c > 0u) ? 1u : 0u; mine = (j == x) ? c : mine; }
        if (sum == G) break;
        __builtin_amdgcn_s_sleep(1);
        if ((++sp & 255u) == 0u) { if (xb_ld(&bar[XB_TMO])) break; if (sp > XB_SPIN_CAP) { atomicAdd(&bar[XB_TMO], 1u); break; } }
    }
    nloc = mine > 0u ? mine : 1u; nx = cnt > 0u ? cnt : 1u;
}
__device__ __forceinline__ void xcd_barrier(unsigned* bar_, volatile LAS unsigned* st_) {
    XcdBarrier b; b.bar = bar_; b.x = xb_xcc_id(); b.st = st_;
    asm volatile("s_waitcnt vmcnt(0)" ::: "memory");
    __syncthreads();
    if (threadIdx.x == 0) {
        unsigned* bar = b.bar;
        __builtin_amdgcn_s_waitcnt(0);
        unsigned nloc = b.st[0], nx = b.st[1];
        if (nloc == 0u) { xcd_barrier_complete(bar, b.x, nloc, nx); b.st[0] = nloc; b.st[1] = nx; }
        const unsigned old = xb_add(&bar[XB_XSUB(b.x)], 1u);
        const unsigned gen = old / nloc;
        if (old + 1u == (gen + 1u) * nloc) {
            __builtin_amdgcn_fence(__ATOMIC_RELEASE, "agent");
            asm volatile("s_waitcnt vmcnt(0)" ::: "memory");
            const unsigned og = xb_add(&bar[XB_TOP], 1u);
            const unsigned tg = og / nx;
            if (og + 1u == (tg + 1u) * nx) xb_add(&bar[XB_TOPGEN], 1u);
            else XB_SPIN(xb_ld(&bar[XB_TOPGEN]) == tg, bar);
            __builtin_amdgcn_fence(__ATOMIC_ACQUIRE, "agent");
            xb_add(&bar[XB_XGEN(b.x)], 1u);
            asm volatile("s_waitcnt vmcnt(0)" ::: "memory");
        } else {
            XB_SPIN(xb_ld(&bar[XB_XGEN(b.x)]) == gen, bar);
            __builtin_amdgcn_fence(__ATOMIC_ACQUIRE, "agent");
            asm volatile("s_waitcnt vmcnt(0)" ::: "memory");
        }
    }
    __syncthreads();
}

__global__ void __launch_bounds__(NTHREADS, 2) mk_fwd(Args a) {
    extern __shared__ __attribute__((aligned(16))) unsigned char lds_raw[];
    LAS unsigned char* lds = (LAS unsigned char*)lds_raw;
    cg::grid_group grid = cg::this_grid();
    const int bid = blockIdx.x, G = gridDim.x;
    volatile LAS unsigned* bst = (volatile LAS unsigned*)(lds + LDS_BYTES - 64);
    if (threadIdx.x < 2) bst[threadIdx.x] = 0u;
    __syncthreads();
    (void)xcd_barrier_post((unsigned*)(a.ws + WS_BAR), bst);
    if (a.pad0 != 0) grid.sync();
#define RUN_P0 p0_prologue(a, lds, bid, G)
#define RUN_P1 do { p1_transposes(a, lds, bid, G); p1_norm(a, bid, G); } while (0)
#define RUN_P2 do { pg8::Gemm g{(const bf16*)a.out, (const bf16*)(a.ws + WS_WTIN), MT, NINP, D, D}; \
        pg8::StaticOrder S; S.init(MT, NINP, D, G, bid); \
        pg8::EpiIn E{(bf16*)(a.ws + WS_ACT), (bf16*)(a.ws + WS_XBC), (float*)(a.ws + WS_DTR)}; \
        pg8::gemm_phase<pg8::EpiIn, pg8::StaticOrder>(lds, g, S, E); } while (0)
#define RUN_P3 p3_states(a, lds, bid, G)
#define RUN_P4 p4_scan(a, bid, G)
#define RUN_P5 p5_mix(a, lds, bid, G)
#define RUN_P6 do { pg8::Gemm g{(const bf16*)(a.ws + WS_ACT) + 1024, (const bf16*)(a.ws + WS_WTOUT), MT, D, 2048, LDACT}; \
        pg8::SplitOrder S; S.init(G, bid); \
        pg8::EpiOut E{(const float*)(a.ws + WS_MOD), (const float*)(a.ws + WS_SS), (bf16*)(a.ws + WS_DELTA), (float*)(a.ws + WS_OUTS)}; \
        pg8::gemm_phase<pg8::EpiOut, pg8::SplitOrder>(lds, g, S, E); } while (0)
#define RUN_P7 p7_final(a, bid, G)
#define SYNC xcd_barrier((unsigned*)(a.ws + WS_BAR), (volatile LAS unsigned*)(lds + LDS_BYTES - 64))
    RUN_P0; SYNC; RUN_P1; SYNC; RUN_P2; SYNC; RUN_P3; SYNC; RUN_P4; SYNC; RUN_P5; SYNC; RUN_P6; SYNC; RUN_P7;
}

#ifdef PROBE_LIST
template <int PH> __global__ void __launch_bounds__(NTHREADS, 2) mk_one(Args a) {
    extern __shared__ __attribute__((aligned(16))) unsigned char lds_raw[];
    LAS unsigned char* lds = (LAS unsigned char*)lds_raw;
    const int bid = blockIdx.x, G = gridDim.x;
    if constexpr (PH == 0) p0_prologue(a, lds, bid, G);
    if constexpr (PH == 1) { p1_transposes(a, lds, bid, G); p1_norm(a, bid, G); }
    if constexpr (PH == 2) { pg8::Gemm g{(const bf16*)a.out, (const bf16*)(a.ws + WS_WTIN), MT, NINP, D, D};
        pg8::StaticOrder S; S.init(MT, NINP, D, G, bid);
        pg8::EpiIn E{(bf16*)(a.ws + WS_ACT), (bf16*)(a.ws + WS_XBC), (float*)(a.ws + WS_DTR)};
        pg8::gemm_phase<pg8::EpiIn, pg8::StaticOrder>(lds, g, S, E); }
    if constexpr (PH == 3) p3_states(a, lds, bid, G);
    if constexpr (PH == 4) p4_scan(a, bid, G);
    if constexpr (PH == 5) p5_mix(a, lds, bid, G);
    if constexpr (PH == 6) { pg8::Gemm g{(const bf16*)(a.ws + WS_ACT) + 1024, (const bf16*)(a.ws + WS_WTOUT), MT, D, 2048, LDACT};
        pg8::SplitOrder S; S.init(G, bid);
        pg8::EpiOut E{(const float*)(a.ws + WS_MOD), (const float*)(a.ws + WS_SS), (bf16*)(a.ws + WS_DELTA), (float*)(a.ws + WS_OUTS)};
        pg8::gemm_phase<pg8::EpiOut, pg8::SplitOrder>(lds, g, S, E); }
    if constexpr (PH == 7) p7_final(a, bid, G);
}
template <int PH> static void launch_one(const Args& a, int grid, hipStream_t stream) {
    static bool init = false;
    if (!init) { (void)hipFuncSetAttribute((const void*)mk_one<PH>, hipFuncAttributeMaxDynamicSharedMemorySize, LDS_BYTES); init = true; }
    hipLaunchKernelGGL(mk_one<PH>, dim3(grid), dim3(NTHREADS), LDS_BYTES, stream, a);
}
#endif

extern "C" void kernel_launch(void* const* d_in, const int* in_sizes, int n_in, void* d_out, int out_size, void* d_ws, size_t ws_size, hipStream_t stream) {
    static int grid = 0;
    if (grid == 0) {
        if (n_in != 21 || out_size != (int)O_END || ws_size < WS_END) { fprintf(stderr, "kernel_launch: unexpected sizes n_in %d out %d ws %zu\n", n_in, out_size, ws_size); grid = -1; return; }
        int dev = 0, cus = 0, per_cu = 0;
        hipGetDevice(&dev);
        hipDeviceGetAttribute(&cus, hipDeviceAttributeMultiprocessorCount, dev);
        hipFuncSetAttribute((const void*)mk_fwd, hipFuncAttributeMaxDynamicSharedMemorySize, LDS_BYTES);
        hipOccupancyMaxActiveBlocksPerMultiprocessor(&per_cu, (const void*)mk_fwd, NTHREADS, LDS_BYTES);
        if (per_cu < 1) { fprintf(stderr, "kernel_launch: occupancy query says %d blocks per CU\n", per_cu); grid = -1; return; }
        grid = cus;
    }
    if (grid < 0) return;
    Args a{};
    for (int i = 0; i < 21; ++i) a.in[i] = (const float*)d_in[i];
    a.out = (float*)d_out; a.ws = (unsigned char*)d_ws;
#ifdef PROBE_LIST
    const int plist[] = PROBE_LIST;
    for (int ph : plist) {
        switch (ph) { case 0: launch_one<0>(a, grid, stream); break; case 1: launch_one<1>(a, grid, stream); break; case 2: launch_one<2>(a, grid, stream); break; case 3: launch_one<3>(a, grid, stream); break;
            case 4: launch_one<4>(a, grid, stream); break; case 5: launch_one<5>(a, grid, stream); break; case 6: launch_one<6>(a, grid, stream); break; default: launch_one<7>(a, grid, stream); break; }
    }
#else
    (void)hipMemsetAsync((char*)d_ws + WS_BAR, 0, XCD_BAR_WORDS * 4, stream);
    void* args[] = {&a};
    hipError_t e = hipLaunchCooperativeKernel((const void*)mk_fwd, dim3(grid), dim3(NTHREADS), args, LDS_BYTES, stream);
    if (e != hipSuccess) fprintf(stderr, "cooperative launch failed: %s\n", hipGetErrorString(e));
#endif
}
```

```cpp
#include <hip/hip_runtime.h>
#include <hip/hip_cooperative_groups.h>
#include <cstdio>
#include <cstdint>
namespace cg = cooperative_groups;


#define LAS __attribute__((address_space(3)))
typedef unsigned short bf16;
typedef short bf16x8 __attribute__((ext_vector_type(8)));
typedef float f32x4 __attribute__((ext_vector_type(4)));
typedef float f32x2 __attribute__((ext_vector_type(2)));
typedef unsigned u32x4 __attribute__((ext_vector_type(4)));
typedef unsigned u32x2 __attribute__((ext_vector_type(2)));

constexpr int D = 1024, MP = 32768, MS = 1024, MT = MP + MS;
constexpr int NSEQ = 18, NCHUNK = MT / 64;
constexpr int NIN = 7184, NINP = 7424;
constexpr int DXBC = 2048, LDACT = 3072;
constexpr float EPS = 1e-5f;
constexpr int NTHREADS = 512;
constexpr int LDS_BYTES = 147456;

constexpr size_t MiB = 1u << 20;
constexpr size_t WS_MOD = 0;
constexpr size_t WS_WTIN = 1 * MiB;
constexpr size_t WS_WTOUT = 16 * MiB;
constexpr size_t WS_SS = 20 * MiB;
constexpr size_t WS_SSF = 22 * MiB;
constexpr size_t WS_CD = 25 * MiB;
constexpr size_t WS_DTR = 26 * MiB;
constexpr size_t WS_DTV = 29 * MiB;
constexpr size_t WS_ACU = 32 * MiB;
constexpr size_t WS_BAR = 35 * MiB;
constexpr size_t WS_ACT = 36 * MiB;
constexpr size_t WS_XBC = 234 * MiB;
constexpr size_t WS_ST = 366 * MiB;
constexpr size_t WS_OUTS = WS_XBC;
constexpr size_t WS_DELTA = WS_XBC + 32 * MiB;
constexpr size_t WS_END = 498 * MiB;
constexpr int XSI_UNIT = 256 * 72, BNI_UNIT = 64 * 136;
constexpr size_t BNI_OFF = 80 * MiB;
constexpr int NRUN = 256;
constexpr size_t RA_OFF = 116 * MiB;
constexpr size_t WS_RD = 25 * MiB + 64 * 1024;
constexpr size_t WS_CDP = 25 * MiB + 128 * 1024;

#define NT_ST(ptr, val) __builtin_nontemporal_store((val), (ptr))
#define NT_LD(ptr) __builtin_nontemporal_load(ptr)
__device__ __forceinline__ unsigned cvt_pk_bf16(float lo, float hi) { unsigned r; asm volatile("v_cvt_pk_bf16_f32 %0, %1, %2" : "=v"(r) : "v"(lo), "v"(hi)); return r; }
__device__ __forceinline__ float bf2f(unsigned b) { return __uint_as_float(b << 16); }
__device__ __forceinline__ float bflo(unsigned w) { return __uint_as_float(w << 16); }
__device__ __forceinline__ float bfhi(unsigned w) { return __uint_as_float(w & 0xffff0000u); }
__device__ __forceinline__ float silu_f(float v) { return v * __builtin_amdgcn_rcpf(1.f + __expf(-v)); }
__device__ __forceinline__ float wave_sum(float v) {
#pragma unroll
    for (int o = 1; o < 64; o <<= 1) v += __shfl_xor(v, o);
    return v;
}
__device__ __forceinline__ int seq_of_row(int row) { return row < MP ? (row >> 14) : 2 + ((row - MP) >> 6); }

namespace pg8 {
constexpr int BM = 256, BK = 64, HALF = 128, HTB = HALF * BK * 2, STAGE_BYTES = 8 * HTB, NXCD = 8, WGM = 8;
__host__ __device__ __forceinline__ int lds_byte(int r, int c) { const int st = (r >> 4) * 2 + (c >> 5), rr = r & 15, cc = c & 31, ob = rr * 64 + cc * 2; return st * 1024 + (ob ^ (((ob >> 9) & 1) << 5)); }
__host__ __device__ __forceinline__ void stage_rc(int b, int& R, int& C) { const int st = b / 1024, sb = b % 1024, swz = sb ^ (((sb >> 9) & 1) << 5); R = (st >> 1) * 16 + swz / 64; C = (st & 1) * 32 + (swz % 64) / 2; }
__host__ __device__ __forceinline__ int perm32(int rho) { const int n = rho >> 4, i = rho & 15; return 8 * (i >> 2) + 4 * n + (i & 3); }
struct Unit { int pm, pn, k0, nt; };
struct Gemm { const bf16* A; const bf16* Bt; int M, N, K, lda; };
struct StaticOrder {
    int nM, nN, nwg, G, c, ntf;
    __device__ void init(int M, int N, int K, int G_, int c_) { nM = M / BM; nN = N / BM; nwg = nM * nN; G = G_; c = c_; ntf = K / BK; }
    __device__ bool next(int i, Unit& u) const {
        const long L = (long)i * G + c; if (L >= nwg) return false;
        u.k0 = 0; u.nt = ntf;
        int wgid = (int)L; { const int q = nwg / NXCD, r = nwg % NXCD, xcd = wgid % NXCD, off = wgid / NXCD; wgid = (xcd < r ? xcd * (q + 1) : r * (q + 1) + (xcd - r) * q) + off; }
        const int nig = WGM * nN, gid = wgid / nig, fm = gid * WGM, gsz = (nM - fm) < WGM ? (nM - fm) : WGM;
        u.pm = fm + ((wgid % nig) % gsz); u.pn = (wgid % nig) / gsz; return true;
    }
};

struct SplitOrder {
    StaticOrder main; int nmain, G, c;
    __device__ void init(int G_, int c_) { main.init(MP, D, 2048, G_, c_); nmain = main.nwg; G = G_; c = c_; }
    __device__ bool next(int i, Unit& u) const {
        const long L = (long)i * G + c;
        if (L < nmain) return main.next(i, u);
        const int r = (int)(L - nmain); if (r >= 128) return false;
        u.pm = MP / BM + (r >> 5); u.pn = (r & 31) >> 3; u.k0 = (r & 7) * 256; u.nt = 4; return true;
    }
};

template <class Epi, class Order>
__device__ __forceinline__ void gemm_phase(LAS unsigned char* lds, const Gemm g, const Order& S, const Epi& E) {
    int tid = threadIdx.x; asm volatile("" : "+v"(tid));
    const int wid = __builtin_amdgcn_readfirstlane(tid >> 6), lane = tid & 63, wr = wid >> 2, wc = wid & 3, fr = lane & 15, fq = lane >> 4;
    const int K = g.K, lda = g.lda;
    unsigned voffA[2], voffB[2];
#pragma unroll
    for (int i = 0; i < 2; ++i) { int R, C; stage_rc(tid * 16 + i * 8192, R, C); const int Rb = Epi::PERM ? ((R & ~31) + perm32(R & 31)) : R;
        voffA[i] = (unsigned)(R * lda + C) * 2u; voffB[i] = (unsigned)(Rb * K + C) * 2u; }
    const size_t kstep = (size_t)(BK * 2);
    const size_t hstepA = (size_t)HALF * lda * 2, tstepA = 2 * hstepA;
    const size_t hstepB = (size_t)HALF * K * 2, tstepB = 2 * hstepB;
    const unsigned ldsw = (unsigned)wid * 1024u;
    const int aoff = lds_byte(wr * 64 + fr, fq * 8), boff = lds_byte(wc * 32 + fr, fq * 8);
#define PG8_SA(b, h) (((b) * 2 + (h)) * HTB)
#define PG8_SB(b, h) ((4 + (b) * 2 + (h)) * HTB)
#define PG8_STAGE(bufoff, gbase, voff) do { _Pragma("unroll") for (int _i = 0; _i < 2; ++_i) \
        __builtin_amdgcn_global_load_lds((const unsigned*)((const char*)(gbase) + (voff)[_i]), (LAS unsigned*)(lds + (bufoff) + ldsw + _i * 8192), 16, 0, 0); } while (0)
#define PG8_LDA(dst, b, h) do { _Pragma("unroll") for (int m = 0; m < 4; ++m) _Pragma("unroll") for (int k = 0; k < 2; ++k) dst[m][k] = *(const LAS bf16x8*)(lds + PG8_SA(b, h) + aoff + m * 2048 + k * 1024); } while (0)
#define PG8_LDB(dst, b, h) do { _Pragma("unroll") for (int n = 0; n < 2; ++n) _Pragma("unroll") for (int k = 0; k < 2; ++k) dst[n][k] = *(const LAS bf16x8*)(lds + PG8_SB(b, h) + boff + n * 2048 + k * 1024); } while (0)
#define PG8_MMA(ai, bj, At, Bt) do { __builtin_amdgcn_s_setprio(1); _Pragma("unroll") for (int m = 0; m < 4; ++m) _Pragma("unroll") for (int n = 0; n < 2; ++n) _Pragma("unroll") for (int k = 0; k < 2; ++k) \
        acc[ai][bj][m][n] = __builtin_amdgcn_mfma_f32_16x16x32_bf16(Bt[n][k], At[m][k], acc[ai][bj][m][n], 0, 0, 0); __builtin_amdgcn_s_setprio(0); } while (0)
#define PG8_WAIT_V(n) asm volatile("s_waitcnt vmcnt(" #n ")" ::: "memory")
#define PG8_WAIT_L(n) asm volatile("s_waitcnt lgkmcnt(" #n ")" ::: "memory")
#define PG8_BAR __builtin_amdgcn_s_barrier()
#define PG8_SCHED __builtin_amdgcn_sched_barrier(0)
    Unit cur, nxt; int ui = 0;
    if (!S.next(0, cur)) return;
    f32x4 acc[2][2][4][2];
#pragma unroll
    for (int a = 0; a < 2; ++a)
#pragma unroll
        for (int b = 0; b < 2; ++b)
#pragma unroll
            for (int m = 0; m < 4; ++m)
#pragma unroll
                for (int n = 0; n < 2; ++n) acc[a][b][m][n] = (f32x4){0.f, 0.f, 0.f, 0.f};
    bf16x8 At[4][2], B0[2][2], B1[2][2];
    const char* cA = (const char*)g.A + (size_t)cur.pm * tstepA + (size_t)cur.k0 * 2; const char* cB = (const char*)g.Bt + (size_t)cur.pn * tstepB + (size_t)cur.k0 * 2;
    PG8_STAGE(PG8_SB(0, 0), cB, voffB); PG8_STAGE(PG8_SB(0, 1), cB + hstepB, voffB); PG8_STAGE(PG8_SA(0, 0), cA, voffA); PG8_STAGE(PG8_SA(0, 1), cA + hstepA, voffA);
    if (wr == 1) PG8_BAR;
    PG8_WAIT_V(2); PG8_BAR;
    PG8_STAGE(PG8_SB(1, 0), cB + kstep, voffB); PG8_STAGE(PG8_SA(1, 0), cA + kstep, voffA); PG8_STAGE(PG8_SB(1, 1), cB + hstepB + kstep, voffB);
    PG8_WAIT_V(6); PG8_BAR;
    for (;;) {
        const bool has_next = S.next(ui + 1, nxt);
        const char* nA = has_next ? (const char*)g.A + (size_t)nxt.pm * tstepA + (size_t)nxt.k0 * 2 : cA; const char* nB = has_next ? (const char*)g.Bt + (size_t)nxt.pn * tstepB + (size_t)nxt.k0 * 2 : cB;
        const int nt = cur.nt;
        for (int t = 0; t < nt; t += 2) {
            const bool last = (t == nt - 2);
            const char* a1 = cA + (size_t)(t + 1) * kstep;
            const char* a2 = last ? nA : cA + (size_t)(t + 2) * kstep; const char* b2 = last ? nB : cB + (size_t)(t + 2) * kstep;
            const char* a3 = a2 + kstep; const char* b3 = b2 + kstep;
            if constexpr (Epi::HAS_MID) { if (t == 16 && nt == 32) E.mid(acc, cur, wr, fr); }
            PG8_LDB(B0, 0, 0); PG8_LDB(B1, 0, 1); PG8_SCHED; PG8_LDA(At, 0, 0); PG8_STAGE(PG8_SA(1, 1), a1 + hstepA, voffA);
            PG8_WAIT_V(8); PG8_WAIT_L(0); PG8_BAR; PG8_MMA(0, 0, At, B0); PG8_MMA(0, 1, At, B1); PG8_BAR; PG8_SCHED;
            PG8_LDA(At, 0, 1); PG8_STAGE(PG8_SB(0, 0), b2, voffB); PG8_STAGE(PG8_SB(0, 1), b2 + hstepB, voffB); PG8_STAGE(PG8_SA(0, 0), a2, voffA);
            PG8_WAIT_V(8); PG8_WAIT_L(0); PG8_BAR; PG8_MMA(1, 0, At, B0); PG8_MMA(1, 1, At, B1); PG8_BAR; PG8_SCHED;
            PG8_LDB(B0, 1, 0); PG8_LDB(B1, 1, 1); PG8_SCHED; PG8_LDA(At, 1, 0); PG8_STAGE(PG8_SA(0, 1), a2 + hstepA, voffA);
            PG8_WAIT_V(8); PG8_WAIT_L(0); PG8_BAR; PG8_MMA(0, 0, At, B0); PG8_MMA(0, 1, At, B1); PG8_BAR; PG8_SCHED;
            PG8_LDA(At, 1, 1); PG8_STAGE(PG8_SB(1, 0), b3, voffB); PG8_STAGE(PG8_SB(1, 1), b3 + hstepB, voffB); PG8_STAGE(PG8_SA(1, 0), a3, voffA);
            PG8_WAIT_V(8); PG8_WAIT_L(0); PG8_BAR; PG8_MMA(1, 0, At, B0); PG8_MMA(1, 1, At, B1); PG8_BAR; PG8_SCHED;
        }
        if (wr == 0) PG8_BAR;
        E(acc, cur, wr, wc, fr, fq);
        if (!has_next) break;
#pragma unroll
        for (int a = 0; a < 2; ++a)
#pragma unroll
            for (int b = 0; b < 2; ++b)
#pragma unroll
                for (int m = 0; m < 4; ++m)
#pragma unroll
                    for (int n = 0; n < 2; ++n) acc[a][b][m][n] = (f32x4){0.f, 0.f, 0.f, 0.f};
        cur = nxt; cA = nA; cB = nB; ++ui;
        if (wr == 1) PG8_BAR;
    }
    PG8_WAIT_V(0);
    PG8_BAR;
#undef PG8_SA
#undef PG8_SB
#undef PG8_STAGE
#undef PG8_LDA
#undef PG8_LDB
#undef PG8_MMA
#undef PG8_WAIT_V
#undef PG8_WAIT_L
#undef PG8_BAR
#undef PG8_SCHED
}

struct EpiIn {
    static constexpr bool PERM = true, HAS_MID = false;
    bf16* ACT; bf16* XBC; float* DTR;
    __device__ __forceinline__ void operator()(const f32x4 (&acc)[2][2][4][2], const Unit& u, int wr, int wc, int fr, int fq) const {
        const int row0 = u.pm * BM + wr * 64 + fr;
        if (u.pn < 16) {
            bf16* base = ACT + (wc < 2 ? 0 : 1024) + 64 * u.pn + 32 * (wc & 1) + 8 * fq;
#pragma unroll
            for (int ai = 0; ai < 2; ++ai)
#pragma unroll
                for (int m = 0; m < 4; ++m) {
                    const f32x4 a0 = acc[ai][0][m][0], a1 = acc[ai][0][m][1], b0 = acc[ai][1][m][0], b1 = acc[ai][1][m][1];
                    f32x4 v0, v1;
                    if (wc < 2) { v0 = a0 * b0; v1 = a1 * b1; }
                    else {
#pragma unroll
                        for (int j = 0; j < 4; ++j) { v0[j] = a0[j] * silu_f(b0[j]); v1[j] = a1[j] * silu_f(b1[j]); }
                    }
                    u32x4 w; w.x = cvt_pk_bf16(v0[0], v0[1]); w.y = cvt_pk_bf16(v0[2], v0[3]); w.z = cvt_pk_bf16(v1[0], v1[1]); w.w = cvt_pk_bf16(v1[2], v1[3]);
                    *(u32x4*)(base + (size_t)(row0 + ai * HALF + m * 16) * LDACT) = w;
                }
        } else if (u.pn < 28) {
            bf16* base; int ld;
            if (u.pn < 20) { base = ACT + 2048 + (u.pn - 16) * 256 + 32 * wc + 8 * fq; ld = LDACT; }
            else { base = XBC + (u.pn - 20) * 256 + 32 * wc + 8 * fq; ld = DXBC; }
#pragma unroll
            for (int ai = 0; ai < 2; ++ai)
#pragma unroll
                for (int m = 0; m < 4; ++m) {
                    bf16* rowp = base + (size_t)(row0 + ai * HALF + m * 16) * ld;
#pragma unroll
                    for (int bj = 0; bj < 2; ++bj) {
                        const f32x4 v0 = acc[ai][bj][m][0], v1 = acc[ai][bj][m][1];
                        u32x4 w; w.x = cvt_pk_bf16(v0[0], v0[1]); w.y = cvt_pk_bf16(v0[2], v0[3]); w.z = cvt_pk_bf16(v1[0], v1[1]); w.w = cvt_pk_bf16(v1[2], v1[3]);
                        *(u32x4*)(rowp + bj * HALF) = w;
                    }
                }
        } else {
            if (wc == 0 && fq < 2) {
#pragma unroll
                for (int ai = 0; ai < 2; ++ai)
#pragma unroll
                    for (int m = 0; m < 4; ++m) {
                        float* p = DTR + (size_t)(row0 + ai * HALF + m * 16) * 16 + 8 * fq;
                        *(f32x4*)p = acc[ai][0][m][0]; *(f32x4*)(p + 4) = acc[ai][0][m][1];
                    }
            }
        }
    }
};

struct EpiOut {
    static constexpr bool PERM = true, HAS_MID = true;
    const float* MOD; const float* SS; bf16* DELTA; float* OUTS;
    __device__ __forceinline__ void mid(f32x4 (&acc)[2][2][4][2], const Unit& u, int wr, int fr) const {
        int rbase = u.pm * BM + wr * 64 + fr;
        asm volatile("" : "+v"(rbase));
#pragma unroll
        for (int ai = 0; ai < 2; ++ai)
#pragma unroll
            for (int m = 0; m < 4; ++m) {
                const int row = rbase + ai * HALF + m * 16;
                const f32x4 sa = *(const f32x4*)(SS + (size_t)row * 8), sb = *(const f32x4*)(SS + (size_t)row * 8 + 4);
                const float va = (sa[0] + sa[1]) + (sa[2] + sa[3]), vb = (sb[0] + sb[1]) + (sb[2] + sb[3]);
                const float tb = vb * (1.f / 1024.f) + EPS;
                const float ratio = rsqrtf(va * (1.f / 1024.f) + EPS) * (tb * rsqrtf(tb));
#pragma unroll
                for (int bj = 0; bj < 2; ++bj)
#pragma unroll
                    for (int n = 0; n < 2; ++n) acc[ai][bj][m][n] *= ratio;
                __builtin_amdgcn_sched_barrier(0);
            }
    }
    __device__ __forceinline__ void operator()(const f32x4 (&acc)[2][2][4][2], const Unit& u, int wr, int wc, int fr, int fq) const {
        const int col0 = u.pn * BM + wc * 32 + 8 * fq;
        if (u.nt != 32) {
#pragma unroll
            for (int ai = 0; ai < 2; ++ai)
#pragma unroll
                for (int m = 0; m < 4; ++m) {
                    const int row = u.pm * BM + ai * HALF + wr * 64 + m * 16 + fr;
                    const f32x4 sv = *(const f32x4*)(SS + (size_t)row * 8 + (u.k0 < 1024 ? 0 : 4));
                    const float rs = rsqrtf(((sv[0] + sv[1]) + (sv[2] + sv[3])) * (1.f / 1024.f) + EPS);
                    float* op = OUTS + ((size_t)(u.k0 >> 8) * MS + (row - MP)) * D + col0;
#pragma unroll
                    for (int bj = 0; bj < 2; ++bj)
#pragma unroll
                        for (int n = 0; n < 2; ++n) *(f32x4*)(op + bj * HALF + n * 4) = acc[ai][bj][m][n] * rs;
                }
            return;
        }
        const float* gp = MOD + (u.pm >> 6) * 3072 + 2048 + col0;
        f32x4 gv[2][2];
#pragma unroll
        for (int bj = 0; bj < 2; ++bj)
#pragma unroll
            for (int n = 0; n < 2; ++n) gv[bj][n] = *(const f32x4*)(gp + bj * HALF + n * 4);
#pragma unroll
        for (int ai = 0; ai < 2; ++ai)
#pragma unroll
            for (int m = 0; m < 4; ++m) {
                const int row = u.pm * BM + ai * HALF + wr * 64 + m * 16 + fr;
                const f32x4 sb = *(const f32x4*)(SS + (size_t)row * 8 + 4);
                const float rb = rsqrtf(((sb[0] + sb[1]) + (sb[2] + sb[3])) * (1.f / 1024.f) + EPS);
                bf16* op = DELTA + (size_t)row * D + col0;
#pragma unroll
                for (int bj = 0; bj < 2; ++bj) {
                    const f32x4 v0 = gv[bj][0] * (acc[ai][bj][m][0] * rb), v1 = gv[bj][1] * (acc[ai][bj][m][1] * rb);
                    u32x4 w; w.x = cvt_pk_bf16(v0[0], v0[1]); w.y = cvt_pk_bf16(v0[2], v0[3]); w.z = cvt_pk_bf16(v1[0], v1[1]); w.w = cvt_pk_bf16(v1[2], v1[3]);
                    *(u32x4*)(op + bj * HALF) = w;
                }
            }
    }
};
}

struct Args {
    const float* in[21]; float* out; unsigned char* ws; int pad0, pad1;
};
enum { I_XP = 0, I_XS, I_SCA, I_SCB, I_SSM, I_CP, I_CS, I_WMOD, I_BMOD, I_NIN, I_WIN, I_CAW, I_NAW, I_CBW, I_CBB, I_DTB, I_ALOG, I_DSKIP, I_NBW, I_WOUT, I_NFW };
constexpr size_t O_Y = 0, O_CAP = 34603008, O_CBP = 34607104, O_SSMP = 34619392, O_CAS = 34881536, O_CBS = 34914304, O_SSMS = 35012608, O_END = 37109760;

__device__ __forceinline__ int in_srccol(int n) {
    if (n < 4096) { const int w = n & 255, seg = w >> 6, j = (n >> 8) * 64 + (w & 63); const int off = seg == 0 ? 1024 : (seg == 1 ? 0 : (seg == 2 ? 2048 : 3072)); return off + j; }
    return n < NIN ? n : -1;
}
template <bool IN>
__device__ __forceinline__ void p0_transpose_item(const float* W, int K, int Nsrc, bf16* WT, LAS float* scr, int k0, int n0, int lane) {
    const int nd = n0 + (lane & 31); const int src = IN ? in_srccol(nd) : nd;
#pragma unroll
    for (int i = 0; i < 32; ++i) { const int kk = 2 * i + (lane >> 5); scr[kk * 33 + (lane & 31)] = src >= 0 ? W[(size_t)(k0 + kk) * Nsrc + src] : 0.f; }
    asm volatile("s_waitcnt lgkmcnt(0)" ::: "memory");
    const int c = lane & 7;
#pragma unroll
    for (int j = 0; j < 4; ++j) { const int n = (lane >> 3) + 8 * j; const LAS float* s = scr + (8 * c) * 33 + n;
        u32x4 o; o.x = cvt_pk_bf16(s[0 * 33], s[1 * 33]); o.y = cvt_pk_bf16(s[2 * 33], s[3 * 33]); o.z = cvt_pk_bf16(s[4 * 33], s[5 * 33]); o.w = cvt_pk_bf16(s[6 * 33], s[7 * 33]);
        *(u32x4*)(WT + (size_t)(n0 + n) * K + k0 + 8 * c) = o; }
    asm volatile("s_waitcnt lgkmcnt(0)" ::: "memory");
}

__device__ __forceinline__ void p0_prologue(const Args& a, LAS unsigned char* lds, int bid, int G) {
    int tid = threadIdx.x; asm volatile("" : "+v"(tid));

    for (int item = bid; item < 192; item += G) {
        LAS float* cl = (LAS float*)lds;
        LAS float* red = (LAS float*)(lds + 73728);
        for (int i = tid; i < NSEQ * 1024 / 4; i += NTHREADS) ((LAS f32x4*)cl)[i] = i < 512 ? ((const f32x4*)a.in[I_CP])[i] : ((const f32x4*)a.in[I_CS])[i - 512];
        const int col = tid & 15, kg = tid >> 4, j0 = item * 16;
        const float* wm = a.in[I_WMOD] + (size_t)(kg * 32) * 3072 + j0 + col;
        float w[32];
#pragma unroll
        for (int kk = 0; kk < 32; ++kk) w[kk] = wm[(size_t)kk * 3072];
        __syncthreads();
        float acc[NSEQ];
#pragma unroll
        for (int s = 0; s < NSEQ; ++s) acc[s] = 0.f;
#pragma unroll
        for (int k4 = 0; k4 < 8; ++k4) {
#pragma unroll
            for (int s = 0; s < NSEQ; ++s) { const f32x4 c4 = *(const LAS f32x4*)(cl + s * 1024 + kg * 32 + 4 * k4);
                acc[s] += (c4[0] * w[4 * k4] + c4[1] * w[4 * k4 + 1]) + (c4[2] * w[4 * k4 + 2] + c4[3] * w[4 * k4 + 3]); }
        }
#pragma unroll
        for (int s = 0; s < NSEQ; ++s) red[(kg * NSEQ + s) * 16 + col] = acc[s];
        __syncthreads();
        for (int o = tid; o < NSEQ * 16; o += NTHREADS) { const int s = o >> 4, c = o & 15; float v = a.in[I_BMOD][j0 + c];
#pragma unroll
            for (int k2 = 0; k2 < 32; ++k2) v += red[(k2 * NSEQ + s) * 16 + c];
            ((float*)(a.ws + WS_MOD))[s * 3072 + j0 + c] = v; }
        __syncthreads();
    }
}
__device__ __forceinline__ void p1_transposes(const Args& a, LAS unsigned char* lds, int bid, int G) {
    int tid = threadIdx.x; asm volatile("" : "+v"(tid));
    const int lane = tid & 63, wave = tid >> 6;
    LAS float* scr = (LAS float*)(lds + wave * 16384);
    const int gw = bid * 8 + wave, NGW = G * 8;
    constexpr int I_IN = (NINP / 32) * (D / 64), I_OUT = (D / 32) * (2048 / 64);
    for (int it = gw; it < I_IN + I_OUT; it += NGW) {
        if (it < I_IN) { const int nb = it / (D / 64), kb = it % (D / 64); p0_transpose_item<true>(a.in[I_WIN], D, NIN, (bf16*)(a.ws + WS_WTIN), scr, kb * 64, nb * 32, lane); }
        else { const int r = it - I_IN; const int nb = r / 32, kb = r % 32; p0_transpose_item<false>(a.in[I_WOUT], 2048, D, (bf16*)(a.ws + WS_WTOUT), scr, kb * 64, nb * 32, lane); }
    }
}

__device__ __forceinline__ void p1_norm(const Args& a, int bid, int G) {
    int tid = threadIdx.x; asm volatile("" : "+v"(tid));
    const int lane = tid & 63, wave = tid >> 6;
    const float* MOD = (const float*)(a.ws + WS_MOD); bf16* H = (bf16*)a.out;
    f32x4 nw[4];
#pragma unroll
    for (int j = 0; j < 4; ++j) nw[j] = ((const f32x4*)a.in[I_NIN])[lane + 64 * j];
    for (int row = bid * 8 + wave; row < MT; row += G * 8) {
        const f32x4* xr = (const f32x4*)(row < MP ? a.in[I_XP] + (size_t)row * D : a.in[I_XS] + (size_t)(row - MP) * D);
        const int s = seq_of_row(row);
        f32x4 v[4]; float ss = 0.f;
#pragma unroll
        for (int j = 0; j < 4; ++j) { v[j] = NT_LD(xr + lane + 64 * j); ss += (v[j][0] * v[j][0] + v[j][1] * v[j][1]) + (v[j][2] * v[j][2] + v[j][3] * v[j][3]); }
        const float rstd = rsqrtf(wave_sum(ss) * (1.f / D) + EPS);
        const f32x4* sh = (const f32x4*)(MOD + s * 3072); const f32x4* sc = (const f32x4*)(MOD + s * 3072 + 1024);
        u32x2* o = (u32x2*)(H + (size_t)row * D);
#pragma unroll
        for (int j = 0; j < 4; ++j) { const f32x4 h = v[j] * rstd * nw[j] * (sc[lane + 64 * j] + 1.f) + sh[lane + 64 * j];
            u32x2 w; w.x = cvt_pk_bf16(h[0], h[1]); w.y = cvt_pk_bf16(h[2], h[3]); o[lane + 64 * j] = w; }
    }
}

__device__ __forceinline__ u32x4 pack8(const float (&v)[8]) { u32x4 w; w.x = cvt_pk_bf16(v[0], v[1]); w.y = cvt_pk_bf16(v[2], v[3]); w.z = cvt_pk_bf16(v[4], v[5]); w.w = cvt_pk_bf16(v[6], v[7]); return w; }
__device__ __forceinline__ float rawel(const u32x4& w, int c) { const unsigned x = w[c >> 1]; return (c & 1) ? bfhi(x) : bflo(x); }
__device__ __forceinline__ void conv_load(const bf16* XBC, const float* stb, int cidx, int xcol, int rs, u32x4 (&r)[11]) {
    const bf16* p = XBC + (size_t)(cidx * 64 + 8 * rs - 3) * DXBC + xcol;
#pragma unroll
    for (int k = 3; k < 11; ++k) r[k] = *(const u32x4*)(p + (size_t)k * DXBC);
    if (rs > 0 || (cidx < 512 && (cidx & 255) != 0)) {
#pragma unroll
        for (int k = 0; k < 3; ++k) r[k] = *(const u32x4*)(p + (size_t)k * DXBC);
    } else if (cidx >= 512) {
        const float* s = stb + (size_t)(cidx - 512) * 3 * DXBC + xcol;
#pragma unroll
        for (int k = 0; k < 3; ++k) { const f32x4 a0 = *(const f32x4*)(s + k * DXBC), a1 = *(const f32x4*)(s + k * DXBC + 4);
            r[k].x = cvt_pk_bf16(a0[0], a0[1]); r[k].y = cvt_pk_bf16(a0[2], a0[3]); r[k].z = cvt_pk_bf16(a1[0], a1[1]); r[k].w = cvt_pk_bf16(a1[2], a1[3]); }
    } else {
#pragma unroll
        for (int k = 0; k < 3; ++k) r[k] = (u32x4){0u, 0u, 0u, 0u};
    }
}
struct ConvW { f32x4 w[4][2]; f32x4 b[2]; };
__device__ __forceinline__ void convw_load(const float* cw, const float* cb, int xcol, ConvW& W) {
#pragma unroll
    for (int j = 0; j < 4; ++j) { W.w[j][0] = *(const f32x4*)(cw + j * DXBC + xcol); W.w[j][1] = *(const f32x4*)(cw + j * DXBC + xcol + 4); }
    W.b[0] = *(const f32x4*)(cb + xcol); W.b[1] = *(const f32x4*)(cb + xcol + 4);
}
__device__ __forceinline__ float conv_el(const u32x4 (&r)[11], const ConvW& W, int t, int c) {
    const float v = W.b[c >> 2][c & 3] + W.w[0][c >> 2][c & 3] * rawel(r[t], c) + W.w[1][c >> 2][c & 3] * rawel(r[t + 1], c) + W.w[2][c >> 2][c & 3] * rawel(r[t + 2], c) + W.w[3][c >> 2][c & 3] * rawel(r[t + 3], c);
    return silu_f(v);
}
__device__ __forceinline__ float softplus_f(float x) { return x > 20.f ? x : log1pf(__expf(x)); }

#define WG_BAR() do { asm volatile("s_waitcnt lgkmcnt(0)" ::: "memory"); __builtin_amdgcn_s_barrier(); asm volatile("" ::: "memory"); } while (0)
__device__ __forceinline__ void p3_states(const Args& a, LAS unsigned char* lds, int bid, int G) {
    int tid = threadIdx.x; asm volatile("" : "+v"(tid));
    const int lane = tid & 63, wave = __builtin_amdgcn_readfirstlane(tid >> 6), fr = lane & 15, fq = lane >> 4;
    const bf16* XBC = (const bf16*)(a.ws + WS_XBC); const float* DTR = (const float*)(a.ws + WS_DTR);
    float* DTV = (float*)(a.ws + WS_DTV); float* ACU = (float*)(a.ws + WS_ACU); float* CD = (float*)(a.ws + WS_CD);
    bf16* ST = (bf16*)(a.ws + WS_ST);
    LAS float* dtw2 = (LAS float*)lds; LAS float* cdl2 = (LAS float*)(lds + 2048);
    LAS bf16* xsT = (LAS bf16*)(lds + 4096); LAS bf16* BT = (LAS bf16*)(lds + 40960);
    bf16* XSI = (bf16*)a.out; bf16* BNI = (bf16*)((unsigned char*)a.out + BNI_OFF);
    const int rs = lane & 7, cg = 8 * wave + (lane >> 3);
    bf16* RA = (bf16*)((unsigned char*)a.out + RA_OFF); float* RD = (float*)(a.ws + WS_RD); float* CDP = (float*)(a.ws + WS_CDP);
#define P3_DT(CIDX, GG, BUF, DTRAW) do { if (wave < 4) { const int cidx_ = (CIDX), h_ = 4 * (GG) + wave, row_ = cidx_ * 64 + lane; \
        const float dt = softplus_f((DTRAW) + a.in[I_DTB][h_]); const float da = dt * -__expf(a.in[I_ALOG][h_]); float ac = da; \
        _Pragma("unroll") for (int o = 1; o < 64; o <<= 1) { const float t = __shfl_up(ac, o); if (lane >= o) ac += t; } \
        const float tot = __shfl(ac, 63); \
        dtw2[(BUF) * 256 + lane * 4 + wave] = dt * __expf(tot - ac); \
        DTV[(size_t)row_ * 16 + h_] = dt; ACU[(size_t)row_ * 16 + h_] = ac; \
        if (lane == 63) { const float cdv = __expf(tot); CD[cidx_ * 16 + h_] = cdv; cdl2[(BUF) * 4 + wave] = cdv; } } } while (0)
    for (int rho = bid; rho < NRUN + 64; rho += G) {
      const bool samp = rho >= NRUN;
      const int g = samp ? ((rho - NRUN) & 3) : ((rho >> 5) & 3);
      const int cbase = samp ? 512 + ((rho - NRUN) >> 2) : (rho >> 7) * 256 + (rho & 31) * 8;
      const int nci = samp ? 1 : 8;
      f32x4 acc[4][4];
#pragma unroll
      for (int i = 0; i < 4; ++i)
#pragma unroll
          for (int j = 0; j < 4; ++j) acc[i][j] = (f32x4){0.f, 0.f, 0.f, 0.f};
      float cum = 1.f;
      LAS float* cwl = (LAS float*)(lds + 59392);
      for (int i = tid; i < 5 * 384; i += NTHREADS) { const int j = i / 384, col = i - j * 384; const int xc = col < 256 ? 256 * g + col : 1024 + 128 * g + (col - 256);
          cwl[i] = j < 4 ? a.in[I_CBW][j * DXBC + xc] : a.in[I_CBB][xc]; }
      { const float d0 = DTR[(size_t)(cbase * 64 + lane) * 16 + 4 * g + (wave & 3)]; P3_DT(cbase, g, 0, d0); }
      __syncthreads();
#pragma unroll 1
      for (int ci = 0; ci < nci; ++ci) {
        const int cidx = cbase + ci, unit = cidx * 4 + g, row0 = cidx * 64;
        u32x4 r[11];
        const int xcol = cg < 32 ? 256 * g + 8 * cg : 1024 + 128 * g + 8 * (cg - 32);
        if (wave < 6) conv_load(XBC, a.in[I_SCB], cidx, xcol, rs, r);
        const int pb = ci & 1;
        const float dnext = DTR[(size_t)((ci + 1 < nci ? cidx + 1 : cidx) * 64 + lane) * 16 + 4 * g + (wave & 3)];
        if (wave < 6 && rs == 7 && (cidx >= 512 || (cidx & 255) == 255)) {
            float* op = cidx >= 512 ? a.out + O_CBS + (size_t)(cidx - 512) * 3 * DXBC + xcol : a.out + O_CBP + (size_t)(cidx >> 8) * 3 * DXBC + xcol;
#pragma unroll
            for (int k = 0; k < 3; ++k) { *(f32x4*)(op + k * DXBC) = (f32x4){rawel(r[8 + k], 0), rawel(r[8 + k], 1), rawel(r[8 + k], 2), rawel(r[8 + k], 3)};
                *(f32x4*)(op + k * DXBC + 4) = (f32x4){rawel(r[8 + k], 4), rawel(r[8 + k], 5), rawel(r[8 + k], 6), rawel(r[8 + k], 7)}; }
        }
        if (wave < 4) {
            LAS bf16* dst = xsT + (8 * cg) * 72 + 8 * rs;
            bf16* gi = XSI + (size_t)unit * XSI_UNIT + (8 * cg) * 72 + 8 * rs;
            float sc[8];
#pragma unroll
            for (int t = 0; t < 8; ++t) sc[t] = dtw2[pb * 256 + (8 * rs + t) * 4 + wave];
#pragma unroll
            for (int c = 0; c < 8; ++c) {
                float o[8]; const LAS float* wp = cwl + 8 * cg + c;
                const float w0 = wp[0], w1 = wp[384], w2 = wp[768], w3 = wp[1152], wb = wp[1536];
#pragma unroll
                for (int t = 0; t < 8; ++t) o[t] = silu_f(wb + w0 * rawel(r[t], c) + w1 * rawel(r[t + 1], c) + w2 * rawel(r[t + 2], c) + w3 * rawel(r[t + 3], c));
                *(u32x4*)(gi + c * 72) = pack8(o);
#pragma unroll
                for (int t = 0; t < 8; ++t) o[t] *= sc[t];
                *(LAS u32x4*)(dst + c * 72) = pack8(o);
            }
        } else if (wave < 6) {
            LAS bf16* dst = BT + (8 * (cg - 32)) * 72 + 8 * rs;
            bf16* gi = BNI + (size_t)unit * BNI_UNIT + (8 * rs) * 136 + 8 * (cg - 32);
            u32x4 rowpk[8];
#pragma unroll
            for (int c2 = 0; c2 < 4; ++c2) {
                float o0[8], o1[8]; const LAS float* wp = cwl + 8 * cg + 2 * c2;
                const float w0 = wp[0], w1 = wp[384], w2 = wp[768], w3 = wp[1152], wb = wp[1536], v0 = wp[1], v1 = wp[385], v2 = wp[769], v3 = wp[1153], vb = wp[1537];
#pragma unroll
                for (int t = 0; t < 8; ++t) { o0[t] = silu_f(wb + w0 * rawel(r[t], 2 * c2) + w1 * rawel(r[t + 1], 2 * c2) + w2 * rawel(r[t + 2], 2 * c2) + w3 * rawel(r[t + 3], 2 * c2));
                    o1[t] = silu_f(vb + v0 * rawel(r[t], 2 * c2 + 1) + v1 * rawel(r[t + 1], 2 * c2 + 1) + v2 * rawel(r[t + 2], 2 * c2 + 1) + v3 * rawel(r[t + 3], 2 * c2 + 1)); }
                *(LAS u32x4*)(dst + (2 * c2) * 72) = pack8(o0); *(LAS u32x4*)(dst + (2 * c2 + 1) * 72) = pack8(o1);
#pragma unroll
                for (int t = 0; t < 8; ++t) rowpk[t][c2] = cvt_pk_bf16(o0[t], o1[t]);
            }
#pragma unroll
            for (int t = 0; t < 8; ++t) *(u32x4*)(gi + t * 136) = rowpk[t];
        }
        __syncthreads();
        {
            const int hl = wave >> 1, nh = wave & 1, h = 4 * g + hl;
            const float cdv = cdl2[pb * 4 + hl];
            if (!samp) {
                if (ci > 0) {
                bf16* sp = ST + ((size_t)cidx * 16 + h) * 8192;
#pragma unroll
                for (int i = 0; i < 4; ++i)
#pragma unroll
                    for (int j = 0; j < 4; ++j) { u32x2 w; w.x = cvt_pk_bf16(acc[i][j][0], acc[i][j][1]); w.y = cvt_pk_bf16(acc[i][j][2], acc[i][j][3]);
                        *(u32x2*)(sp + (16 * j + fr) * 128 + 64 * nh + 16 * i + 4 * fq) = w; }
                }
                if (nh == 0 && lane == 0) CDP[cidx * 16 + h] = cum;
#pragma unroll
                for (int i = 0; i < 4; ++i)
#pragma unroll
                    for (int j = 0; j < 4; ++j) acc[i][j] *= cdv;
                cum *= cdv;
            }
#pragma unroll
            for (int ks = 0; ks < 2; ++ks) {
                bf16x8 xf[4], yf[4];
#pragma unroll
                for (int i = 0; i < 4; ++i) xf[i] = *(const LAS bf16x8*)(BT + (64 * nh + 16 * i + fr) * 72 + 32 * ks + 8 * fq);
#pragma unroll
                for (int j = 0; j < 4; ++j) yf[j] = *(const LAS bf16x8*)(xsT + (64 * hl + 16 * j + fr) * 72 + 32 * ks + 8 * fq);
#pragma unroll
                for (int i = 0; i < 4; ++i)
#pragma unroll
                    for (int j = 0; j < 4; ++j) acc[i][j] = __builtin_amdgcn_mfma_f32_16x16x32_bf16(xf[i], yf[j], acc[i][j], 0, 0, 0);
            }
            if (samp) {
                const int b = cidx - 512;
                const float* s0 = a.in[I_SSM] + ((size_t)b * 16 + h) * 8192; float* so = a.out + O_SSMS + ((size_t)b * 16 + h) * 8192;
#pragma unroll
                for (int i = 0; i < 4; ++i)
#pragma unroll
                    for (int j = 0; j < 4; ++j) { const int off = (16 * j + fr) * 128 + 64 * nh + 16 * i + 4 * fq;
                        *(f32x4*)(so + off) = *(const f32x4*)(s0 + off) * cdv + acc[i][j]; }
            }
        }
        if (ci + 1 < nci) P3_DT(cidx + 1, g, pb ^ 1, dnext);
        __syncthreads();
      }
      if (!samp) {
          const int hl = wave >> 1, nh = wave & 1;
          bf16* sp = RA + ((size_t)rho * 4 + hl) * 8192;
#pragma unroll
          for (int i = 0; i < 4; ++i)
#pragma unroll
              for (int j = 0; j < 4; ++j) { u32x2 w; w.x = cvt_pk_bf16(acc[i][j][0], acc[i][j][1]); w.y = cvt_pk_bf16(acc[i][j][2], acc[i][j][3]);
                  *(u32x2*)(sp + (16 * j + fr) * 128 + 64 * nh + 16 * i + 4 * fq) = w; }
          if (nh == 0 && lane == 0) RD[rho * 4 + hl] = cum;
      }
    }
}

__device__ __forceinline__ void p4_scan(const Args& a, int bid, int G) {
    unsigned* RAw = (unsigned*)((unsigned char*)a.out + RA_OFF); const float* RD = (const float*)(a.ws + WS_RD);
    for (int idx = bid * NTHREADS + (int)threadIdx.x; idx < 8 * 16384; idx += G * NTHREADS) {
        const int sg = idx >> 14, e2 = idx & 16383, hl = e2 >> 12;
        float run0 = 0.f, run1 = 0.f;
        unsigned* p = RAw + (size_t)(sg * 32) * 16384 + e2; const float* rd = RD + (sg * 32) * 4 + hl;
        unsigned v[32]; float d[32];
#pragma unroll
        for (int k = 0; k < 32; ++k) { v[k] = p[(size_t)k * 16384]; d[k] = rd[k * 4]; }
#pragma unroll
        for (int k = 0; k < 32; ++k) { p[(size_t)k * 16384] = cvt_pk_bf16(run0, run1); run0 = run0 * d[k] + bflo(v[k]); run1 = run1 * d[k] + bfhi(v[k]); }
        *(f32x2*)(a.out + O_SSMP + (size_t)(sg >> 2) * 131072 + (size_t)(4 * (sg & 3) + hl) * 8192 + 2 * (e2 & 4095)) = (f32x2){run0, run1};
    }
}

__device__ __forceinline__ void p5_mix(const Args& a, LAS unsigned char* lds, int bid, int G) {
    int tid = threadIdx.x; asm volatile("" : "+v"(tid));
    const int lane = tid & 63, wave = __builtin_amdgcn_readfirstlane(tid >> 6), fr = lane & 15, fq = lane >> 4;
    bf16* ACT = (bf16*)(a.ws + WS_ACT); const bf16* XBC = (const bf16*)(a.ws + WS_XBC);
    const float* DTV = (const float*)(a.ws + WS_DTV); const float* ACU = (const float*)(a.ws + WS_ACU);
    const bf16* ST = (const bf16*)(a.ws + WS_ST); float* SS = (float*)(a.ws + WS_SS);
    LAS float* dtv = (LAS float*)lds; LAS float* acu = (LAS float*)(lds + 1024); LAS float* ea = (LAS float*)(lds + 2048);
    LAS float* partA = (LAS float*)(lds + 3072); LAS float* partB = (LAS float*)(lds + 3584);
    LAS bf16* xsT = (LAS bf16*)(lds + 8192); LAS bf16* Bn = (LAS bf16*)(lds + 45056); LAS bf16* Cn = (LAS bf16*)(lds + 62464); LAS bf16* Mh = (LAS bf16*)(lds + 79872);
    const bf16* XSI = (const bf16*)a.out; const bf16* BNI = (const bf16*)((const unsigned char*)a.out + BNI_OFF);
    const int tidp5_ = tid; const int cgc = tid & 15, rs2 = tid >> 4;
    u32x4 im[7], rc[5]; ConvW W; float dt_r, ac_r;
#define P5_LOADS(UNIT) do { const int u_ = (UNIT), cidx_ = u_ >> 2, q_ = u_ & 3; int tid = tidp5_; asm volatile("" : "+v"(tid));   \
        const int cgc = tid & 15, rs2 = tid >> 4, xcol_ = 1536 + 128 * q_ + 8 * cgc; \
        dt_r = DTV[(size_t)(cidx_ * 64 + ((tid & 255) >> 2)) * 16 + 4 * q_ + (tid & 3)]; ac_r = ACU[(size_t)(cidx_ * 64 + ((tid & 255) >> 2)) * 16 + 4 * q_ + (tid & 3)]; \
        const bool sample_ = cidx_ >= 512, first_ = !sample_ && (cidx_ & 255) == 0; \
        const u32x4* xi_ = (const u32x4*)(XSI + (size_t)u_ * XSI_UNIT); const u32x4* bi_ = (const u32x4*)(BNI + (size_t)u_ * BNI_UNIT); \
        _Pragma("unroll") for (int k = 0; k < 7; ++k) { const int idx = tid + NTHREADS * k; if (idx < 2304) im[k] = xi_[idx]; else if (idx < 3392) im[k] = bi_[idx - 2304]; } \
        const int tb_ = 2 * rs2 - 3; \
        _Pragma("unroll") for (int k = 0; k < 5; ++k) { const int tr = tb_ + k; \
            if (tr >= 0 || (!sample_ && !first_)) rc[k] = *(const u32x4*)(XBC + (size_t)(cidx_ * 64 + tr) * DXBC + xcol_); \
            else if (sample_) { const float* sp = a.in[I_SCB] + ((size_t)(cidx_ - 512) * 3 + (3 + tr)) * DXBC + xcol_; const f32x4 a0 = *(const f32x4*)sp, a1 = *(const f32x4*)(sp + 4); \
                rc[k].x = cvt_pk_bf16(a0[0], a0[1]); rc[k].y = cvt_pk_bf16(a0[2], a0[3]); rc[k].z = cvt_pk_bf16(a1[0], a1[1]); rc[k].w = cvt_pk_bf16(a1[2], a1[3]); } \
            else rc[k] = (u32x4){0u, 0u, 0u, 0u}; } \
        convw_load(a.in[I_CBW], a.in[I_CBB], xcol_, W); } while (0)
    if (bid < NCHUNK * 4) P5_LOADS(bid);
    for (int unit = bid; unit < NCHUNK * 4; unit += G) {
        const int cidx = unit >> 2, q = unit & 3, row0 = cidx * 64;
        const bool sample = cidx >= 512, first = !sample && (cidx & 255) == 0, lastc = sample || (cidx & 255) == 255;
        const int xcol = 1536 + 128 * q + 8 * cgc;
        if (tid < 256) { dtv[tid] = dt_r; acu[tid] = ac_r; ea[tid] = __expf(ac_r); }
#pragma unroll
        for (int k = 0; k < 7; ++k) { const int idx = tid + NTHREADS * k; if (idx < 2304) ((LAS u32x4*)xsT)[idx] = im[k]; else if (idx < 3392) ((LAS u32x4*)Bn)[idx - 2304] = im[k]; }
        if (lastc && rs2 == 31) {
            float* op = sample ? a.out + O_CBS + (size_t)(cidx - 512) * 3 * DXBC + xcol : a.out + O_CBP + (size_t)(cidx >> 8) * 3 * DXBC + xcol;
#pragma unroll
            for (int k = 0; k < 3; ++k) { *(f32x4*)(op + k * DXBC) = (f32x4){rawel(rc[2 + k], 0), rawel(rc[2 + k], 1), rawel(rc[2 + k], 2), rawel(rc[2 + k], 3)};
                *(f32x4*)(op + k * DXBC + 4) = (f32x4){rawel(rc[2 + k], 4), rawel(rc[2 + k], 5), rawel(rc[2 + k], 6), rawel(rc[2 + k], 7)}; }
        }
#pragma unroll
        for (int t = 0; t < 2; ++t) {
            float o[8];
#pragma unroll
            for (int c = 0; c < 8; ++c) {
                const float v = W.b[c >> 2][c & 3] + W.w[0][c >> 2][c & 3] * rawel(rc[t], c) + W.w[1][c >> 2][c & 3] * rawel(rc[t + 1], c) + W.w[2][c >> 2][c & 3] * rawel(rc[t + 2], c) + W.w[3][c >> 2][c & 3] * rawel(rc[t + 3], c);
                o[c] = silu_f(v);
            }
            *(LAS u32x4*)(Cn + (2 * rs2 + t) * 136 + 8 * cgc) = pack8(o);
        }
        WG_BAR();
        {
#pragma unroll 1
            for (int tt = 0; tt < 2; ++tt) {
                const int tile = wave * 2 + tt, it = tile >> 2, jt = tile & 3;
                if (jt > it) {
#pragma unroll
                    for (int hl = 0; hl < 4; ++hl) *(LAS u32x2*)(Mh + (hl * 64 + 16 * it + fr) * 72 + 16 * jt + 4 * fq) = (u32x2){0u, 0u};
                    continue;
                }
                f32x4 cb = (f32x4){0.f, 0.f, 0.f, 0.f};
#pragma unroll
                for (int ks = 0; ks < 4; ++ks) {
                    const bf16x8 xf = *(const LAS bf16x8*)(Bn + (16 * jt + fr) * 136 + 32 * ks + 8 * fq);
                    const bf16x8 yf = *(const LAS bf16x8*)(Cn + (16 * it + fr) * 136 + 32 * ks + 8 * fq);
                    cb = __builtin_amdgcn_mfma_f32_16x16x32_bf16(xf, yf, cb, 0, 0, 0);
                }
                const int i = 16 * it + fr, jb = 16 * jt + 4 * fq;
#pragma unroll
                for (int hl = 0; hl < 4; ++hl) {
                    const float ai = acu[i * 4 + hl], dsk = a.in[I_DSKIP][4 * q + hl];
                    float mv[4];
#pragma unroll
                    for (int jj = 0; jj < 4; ++jj) { const int j = jb + jj;
                        float v = (i >= j) ? cb[jj] * __expf(ai - acu[j * 4 + hl]) * dtv[j * 4 + hl] : 0.f;
                        if (i == j) v += dsk;
                        mv[jj] = v; }
                    u32x2 w; w.x = cvt_pk_bf16(mv[0], mv[1]); w.y = cvt_pk_bf16(mv[2], mv[3]);
                    *(LAS u32x2*)(Mh + (hl * 64 + i) * 72 + jb) = w;
                }
            }
        }
        WG_BAR();
            const int ca = lane & 31, ra = 2 * wave + (lane >> 5), ja = 256 * q + 8 * ca, ta = 4 * ra;
            u32x4 ur[6], br[4];
        {
            const int hl = wave >> 1, ph = wave & 1, h = 4 * q + hl;
            float ssqa[4] = {0.f, 0.f, 0.f, 0.f};
            const bool haslp = sample || (cidx & 7) != 0;
#pragma unroll 1
            for (int ptl = 0; ptl < 2; ++ptl) {
                const int p0 = 32 * ph + 16 * ptl;
                bf16x8 sf[4], lf[4]; float cdp = 0.f;
                if (!sample) {
                    const int rho = ((cidx >> 8) * 4 + q) * 32 + ((cidx & 255) >> 3);
                    const bf16* sr = (const bf16*)((const unsigned char*)a.out + RA_OFF) + ((size_t)rho * 4 + hl) * 8192 + (p0 + fr) * 128 + 8 * fq;
                    const bf16* sp = ST + ((size_t)cidx * 16 + h) * 8192 + (p0 + fr) * 128 + 8 * fq;
#pragma unroll
                    for (int ks = 0; ks < 4; ++ks) { sf[ks] = *(const bf16x8*)(sr + 32 * ks); if (haslp) lf[ks] = *(const bf16x8*)(sp + 32 * ks); }
                    cdp = ((const float*)(a.ws + WS_CDP))[cidx * 16 + h];
                } else {
                    const float* sp = a.in[I_SSM] + ((size_t)(cidx - 512) * 16 + h) * 8192 + (p0 + fr) * 128 + 8 * fq;
#pragma unroll
                    for (int ks = 0; ks < 4; ++ks) { const f32x4 v0 = *(const f32x4*)(sp + 32 * ks), v1 = *(const f32x4*)(sp + 32 * ks + 4);
                        u32x4 w; w.x = cvt_pk_bf16(v0[0], v0[1]); w.y = cvt_pk_bf16(v0[2], v0[3]); w.z = cvt_pk_bf16(v1[0], v1[1]); w.w = cvt_pk_bf16(v1[2], v1[3]);
                        lf[ks] = __builtin_bit_cast(bf16x8, w); }
                }
                bf16* zp0 = ACT + (size_t)(row0 + fr) * LDACT + 2048 + 256 * q + 64 * hl + p0 + 4 * fq;
                u32x2 zw[4];
#pragma unroll
                for (int il = 0; il < 4; ++il) zw[il] = *(const u32x2*)(zp0 + (size_t)(16 * il) * LDACT);
                const f32x4 nw4 = *(const f32x4*)(a.in[I_NBW] + 256 * q + 64 * hl + p0 + 4 * fq);
                f32x4 ad[4], ao[4];
#pragma unroll
                for (int il = 0; il < 4; ++il) { ad[il] = (f32x4){0.f, 0.f, 0.f, 0.f}; ao[il] = (f32x4){0.f, 0.f, 0.f, 0.f}; }
#pragma unroll
                for (int ks = 0; ks < 2; ++ks) {
                    const bf16x8 xf = *(const LAS bf16x8*)(xsT + (64 * hl + p0 + fr) * 72 + 32 * ks + 8 * fq);
#pragma unroll
                    for (int il = 0; il < 4; ++il) ad[il] = __builtin_amdgcn_mfma_f32_16x16x32_bf16(xf, *(const LAS bf16x8*)(Mh + (hl * 64 + 16 * il + fr) * 72 + 32 * ks + 8 * fq), ad[il], 0, 0, 0);
                }
                if (!sample) {
#pragma unroll
                    for (int ks = 0; ks < 4; ++ks)
#pragma unroll
                        for (int il = 0; il < 4; ++il) ao[il] = __builtin_amdgcn_mfma_f32_16x16x32_bf16(sf[ks], *(const LAS bf16x8*)(Cn + (16 * il + fr) * 136 + 32 * ks + 8 * fq), ao[il], 0, 0, 0);
#pragma unroll
                    for (int il = 0; il < 4; ++il) ao[il] *= cdp;
                }
                if (haslp) {
#pragma unroll
                for (int ks = 0; ks < 4; ++ks)
#pragma unroll
                    for (int il = 0; il < 4; ++il) ao[il] = __builtin_amdgcn_mfma_f32_16x16x32_bf16(lf[ks], *(const LAS bf16x8*)(Cn + (16 * il + fr) * 136 + 32 * ks + 8 * fq), ao[il], 0, 0, 0);
                }
#pragma unroll
                for (int il = 0; il < 4; ++il) {
                    const float eai = ea[(16 * il + fr) * 4 + hl];
                    const u32x2 zv = zw[il];
                    const f32x4 y = ad[il] + ao[il] * eai;
                    const float g0 = y[0] * silu_f(bflo(zv.x)), g1 = y[1] * silu_f(bfhi(zv.x)), g2 = y[2] * silu_f(bflo(zv.y)), g3 = y[3] * silu_f(bfhi(zv.y));
                    ssqa[il] += (g0 * g0 + g1 * g1) + (g2 * g2 + g3 * g3);
                    u32x2 w; w.x = cvt_pk_bf16(g0 * nw4[0], g1 * nw4[1]); w.y = cvt_pk_bf16(g2 * nw4[2], g3 * nw4[3]);
                    *(u32x2*)(zp0 + (size_t)(16 * il) * LDACT) = w;
                }
            }
#pragma unroll
            for (int il = 0; il < 4; ++il) { float ssq = ssqa[il]; ssq += __shfl_xor(ssq, 16); ssq += __shfl_xor(ssq, 32); if (fq == 0) partB[wave * 64 + 16 * il + fr] = ssq; }
            __builtin_amdgcn_sched_barrier(0);
#pragma unroll
            for (int k = 0; k < 4; ++k) { ur[k + 2] = *(const u32x4*)(ACT + (size_t)(row0 + ta + k) * LDACT + ja); br[k] = *(const u32x4*)(ACT + (size_t)(row0 + ta + k) * LDACT + 1024 + ja); }
            if (ra > 0 || (!sample && !first)) {
#pragma unroll
                for (int k = 0; k < 2; ++k) ur[k] = *(const u32x4*)(ACT + (size_t)(row0 + ta - 2 + k) * LDACT + ja);
            } else if (sample) {
                const float* p = a.in[I_SCA] + (size_t)(cidx - 512) * 2 * D + ja;
#pragma unroll
                for (int k = 0; k < 2; ++k) { const f32x4 x0 = *(const f32x4*)(p + k * D), x1 = *(const f32x4*)(p + k * D + 4);
                    ur[k].x = cvt_pk_bf16(x0[0], x0[1]); ur[k].y = cvt_pk_bf16(x0[2], x0[3]); ur[k].z = cvt_pk_bf16(x1[0], x1[1]); ur[k].w = cvt_pk_bf16(x1[2], x1[3]); }
            } else { ur[0] = (u32x4){0u, 0u, 0u, 0u}; ur[1] = ur[0]; }

        }
        {
            const float* caw = a.in[I_CAW];
            f32x4 w0[2], w1[2], w2[2], nw[2];
#pragma unroll
            for (int hh = 0; hh < 2; ++hh) { w0[hh] = *(const f32x4*)(caw + ja + 4 * hh); w1[hh] = *(const f32x4*)(caw + D + ja + 4 * hh); w2[hh] = *(const f32x4*)(caw + 2 * D + ja + 4 * hh); nw[hh] = *(const f32x4*)(a.in[I_NAW] + ja + 4 * hh); }
#pragma unroll
            for (int k = 0; k < 4; ++k) {
                float y[8], ssq = 0.f;
#pragma unroll
                for (int c = 0; c < 8; ++c) {
                    const float v = rawel(br[k], c) * (w0[c >> 2][c & 3] * rawel(ur[k], c) + w1[c >> 2][c & 3] * rawel(ur[k + 1], c) + w2[c >> 2][c & 3] * rawel(ur[k + 2], c));
                    ssq += v * v; y[c] = v * nw[c >> 2][c & 3];
                }
                *(u32x4*)(ACT + (size_t)(row0 + ta + k) * LDACT + 1024 + ja) = pack8(y);
#pragma unroll
                for (int o = 1; o < 32; o <<= 1) ssq += __shfl_xor(ssq, o);
                if (ca == 0) partA[ta + k] = ssq;
            }
            if (lastc && ra == 15) {
                float* o = sample ? a.out + O_CAS + (size_t)(cidx - 512) * 2 * D + ja : a.out + O_CAP + (size_t)(cidx >> 8) * 2 * D + ja;
#pragma unroll
                for (int k = 0; k < 2; ++k) { *(f32x4*)(o + k * D) = (f32x4){rawel(ur[4 + k], 0), rawel(ur[4 + k], 1), rawel(ur[4 + k], 2), rawel(ur[4 + k], 3)};
                    *(f32x4*)(o + k * D + 4) = (f32x4){rawel(ur[4 + k], 4), rawel(ur[4 + k], 5), rawel(ur[4 + k], 6), rawel(ur[4 + k], 7)}; }
            }
        }
        __builtin_amdgcn_sched_barrier(0);
        __builtin_amdgcn_sched_barrier(0);
        P5_LOADS(unit + G < NCHUNK * 4 ? unit + G : unit);
        WG_BAR();
        if (tid < 64) { SS[(size_t)(row0 + tid) * 8 + q] = partA[tid];
            SS[(size_t)(row0 + tid) * 8 + 4 + q] = ((partB[tid] + partB[64 + tid]) + (partB[128 + tid] + partB[192 + tid])) + ((partB[256 + tid] + partB[320 + tid]) + (partB[384 + tid] + partB[448 + tid])); }
    }
}

__device__ __forceinline__ void p7_final(const Args& a, int bid, int G) {
    int tid = threadIdx.x; asm volatile("" : "+v"(tid));
    const int lane = tid & 63, wave = tid >> 6;
    f32x4 nw[4];
#pragma unroll
    for (int j = 0; j < 4; ++j) nw[j] = ((const f32x4*)a.in[I_NFW])[lane + 64 * j];
    for (int row = bid * 8 + wave; row < MT; row += G * 8) {
        f32x4* yr = (f32x4*)(a.out + (size_t)row * D);
        f32x4 v[4]; float ss = 0.f;
        if (row < MP) {
            const f32x4* xi = (const f32x4*)(a.in[I_XP] + (size_t)row * D); const u32x2* dl = (const u32x2*)((const bf16*)(a.ws + WS_DELTA) + (size_t)row * D);
#pragma unroll
            for (int j = 0; j < 4; ++j) { const u32x2 d = dl[lane + 64 * j]; v[j] = NT_LD(xi + lane + 64 * j) + (f32x4){bflo(d.x), bfhi(d.x), bflo(d.y), bfhi(d.y)}; }
        } else {
            const f32x4* xi = (const f32x4*)(a.in[I_XS] + (size_t)(row - MP) * D); const f32x4* os = (const f32x4*)(a.ws + WS_OUTS) + (size_t)(row - MP) * (D / 4);
            const f32x4* gp = (const f32x4*)((const float*)(a.ws + WS_MOD) + seq_of_row(row) * 3072 + 2048);
#pragma unroll
            for (int j = 0; j < 4; ++j) { f32x4 o = os[lane + 64 * j];
#pragma unroll
                for (int sl = 1; sl < 8; ++sl) o += os[(size_t)sl * MS * (D / 4) + lane + 64 * j];
                v[j] = xi[lane + 64 * j] + gp[lane + 64 * j] * o; }
        }
#pragma unroll
        for (int j = 0; j < 4; ++j) ss += (v[j][0] * v[j][0] + v[j][1] * v[j][1]) + (v[j][2] * v[j][2] + v[j][3] * v[j][3]);
        const float rstd = rsqrtf(wave_sum(ss) * (1.f / D) + EPS);
#pragma unroll
        for (int j = 0; j < 4; ++j) NT_ST(yr + lane + 64 * j, v[j] * rstd * nw[j]);
    }
}

#define XB_TMO      128
#define XB_XCNT(j)  (256  + 64 * (j))
#define XB_XSUB(j)  (1280 + 64 * (j))
#define XB_XGEN(j)  (2304 + 64 * (j))
#define XB_TOP      3328
#define XB_TOPGEN   3392
#define XCD_BAR_WORDS 3456
#define XB_SPIN_CAP (1u << 18)
__device__ __forceinline__ unsigned xb_ld(unsigned* p)              { return __hip_atomic_load(p, __ATOMIC_RELAXED, __HIP_MEMORY_SCOPE_AGENT); }
__device__ __forceinline__ unsigned xb_add(unsigned* p, unsigned v) { return __hip_atomic_fetch_add(p, v, __ATOMIC_RELAXED, __HIP_MEMORY_SCOPE_AGENT); }
__device__ __forceinline__ unsigned xb_xcc_id() { return (unsigned)__builtin_amdgcn_s_getreg((3 << 11) | 20) & 0xFu; }
#define XB_SPIN(cond, bar) do { unsigned _sp = 0; while (cond) { __builtin_amdgcn_s_sleep(1); \
    if ((++_sp & 255u) == 0u) { if (xb_ld(&(bar)[XB_TMO])) break; if (_sp > XB_SPIN_CAP) { atomicAdd(&(bar)[XB_TMO], 1u); break; } } } } while (0)
struct XcdBarrier { unsigned* bar; unsigned x; volatile LAS unsigned* st; };
__device__ __forceinline__ XcdBarrier xcd_barrier_post(unsigned* bar, volatile LAS unsigned* st) {
    XcdBarrier b; b.bar = bar; b.x = xb_xcc_id(); b.st = st;
    if (threadIdx.x == 0) (void)xb_add(&bar[XB_XCNT(b.x)], 1u);
    return b;
}
__device__ __forceinline__ void xcd_barrier_complete(unsigned* bar, unsigned x, unsigned& nloc, unsigned& nx) {
    const unsigned G = gridDim.x * gridDim.y * gridDim.z;
    unsigned sum, cnt, mine, sp = 0u;
    for (;;) {
        sum = 0u; cnt = 0u; mine = 0u;
#pragma unroll
        for (unsigned j = 0; j < 16; ++j) { const unsigned c = xb_ld(&bar[XB_XCNT(j)]); sum += c; cnt += (c > 0u) ? 1u : 0u; mine = (j == x) ? c : mine; }
        if (sum == G) break;
        __builtin_amdgcn_s_sleep(1);
        if ((++sp & 255u) == 0u) { if (xb_ld(&bar[XB_TMO])) break; if (sp > XB_SPIN_CAP) { atomicAdd(&bar[XB_TMO], 1u); break; } }
    }
    nloc = mine > 0u ? mine : 1u; nx = cnt > 0u ? cnt : 1u;
}
__device__ __forceinline__ void xcd_barrier(unsigned* bar_, volatile LAS unsigned* st_) {
    XcdBarrier b; b.bar = bar_; b.x = xb_xcc_id(); b.st = st_;
    asm volatile("s_waitcnt vmcnt(0)" ::: "memory");
    __syncthreads();
    if (threadIdx.x == 0) {
        unsigned* bar = b.bar;
        __builtin_amdgcn_s_waitcnt(0);
        unsigned nloc = b.st[0], nx = b.st[1];
        if (nloc == 0u) { xcd_barrier_complete(bar, b.x, nloc, nx); b.st[0] = nloc; b.st[1] = nx; }
        const unsigned old = xb_add(&bar[XB_XSUB(b.x)], 1u);
        const unsigned gen = old / nloc;
        if (old + 1u == (gen + 1u) * nloc) {
            __builtin_amdgcn_fence(__ATOMIC_RELEASE, "agent");
            asm volatile("s_waitcnt vmcnt(0)" ::: "memory");
            const unsigned og = xb_add(&bar[XB_TOP], 1u);
            const unsigned tg = og / nx;
            if (og + 1u == (tg + 1u) * nx) xb_add(&bar[XB_TOPGEN], 1u);
            else XB_SPIN(xb_ld(&bar[XB_TOPGEN]) == tg, bar);
            __builtin_amdgcn_fence(__ATOMIC_ACQUIRE, "agent");
            xb_add(&bar[XB_XGEN(b.x)], 1u);
            asm volatile("s_waitcnt vmcnt(0)" ::: "memory");
        } else {
            XB_SPIN(xb_ld(&bar[XB_XGEN(b.x)]) == gen, bar);
            __builtin_amdgcn_fence(__ATOMIC_ACQUIRE, "agent");
            asm volatile("s_waitcnt vmcnt(0)" ::: "memory");
        }
    }
    __syncthreads();
}

__global__ void __launch_bounds__(NTHREADS, 2) mk_fwd(Args a) {
    extern __shared__ __attribute__((aligned(16))) unsigned char lds_raw[];
    LAS unsigned char* lds = (LAS unsigned char*)lds_raw;
    cg::grid_group grid = cg::this_grid();
    const int bid = blockIdx.x, G = gridDim.x;
    volatile LAS unsigned* bst = (volatile LAS unsigned*)(lds + LDS_BYTES - 64);
    if (threadIdx.x < 2) bst[threadIdx.x] = 0u;
    __syncthreads();
    (void)xcd_barrier_post((unsigned*)(a.ws + WS_BAR), bst);
    if (a.pad0 != 0) grid.sync();
#define RUN_P0 p0_prologue(a, lds, bid, G)
#define RUN_P1 do { p1_transposes(a, lds, bid, G); p1_norm(a, bid, G); } while (0)
#define RUN_P2 do { pg8::Gemm g{(const bf16*)a.out, (const bf16*)(a.ws + WS_WTIN), MT, NINP, D, D}; \
        pg8::StaticOrder S; S.init(MT, NINP, D, G, bid); \
        pg8::EpiIn E{(bf16*)(a.ws + WS_ACT), (bf16*)(a.ws + WS_XBC), (float*)(a.ws + WS_DTR)}; \
        pg8::gemm_phase<pg8::EpiIn, pg8::StaticOrder>(lds, g, S, E); } while (0)
#define RUN_P3 p3_states(a, lds, bid, G)
#define RUN_P4 p4_scan(a, bid, G)
#define RUN_P5 p5_mix(a, lds, bid, G)
#define RUN_P6 do { pg8::Gemm g{(const bf16*)(a.ws + WS_ACT) + 1024, (const bf16*)(a.ws + WS_WTOUT), MT, D, 2048, LDACT}; \
        pg8::SplitOrder S; S.init(G, bid); \
        pg8::EpiOut E{(const float*)(a.ws + WS_MOD), (const float*)(a.ws + WS_SS), (bf16*)(a.ws + WS_DELTA), (float*)(a.ws + WS_OUTS)}; \
        pg8::gemm_phase<pg8::EpiOut, pg8::SplitOrder>(lds, g, S, E); } while (0)
#define RUN_P7 p7_final(a, bid, G)
#define SYNC xcd_barrier((unsigned*)(a.ws + WS_BAR), (volatile LAS unsigned*)(lds + LDS_BYTES - 64))
    RUN_P0; SYNC; RUN_P1; SYNC; RUN_P2; SYNC; RUN_P3; SYNC; RUN_P4; SYNC; RUN_P5; SYNC; RUN_P6; SYNC; RUN_P7;
}

#ifdef PROBE_LIST
template <int PH> __global__ void __launch_bounds__(NTHREADS, 2) mk_one(Args a) {
    extern __shared__ __attribute__((aligned(16))) unsigned char lds_raw[];
    LAS unsigned char* lds = (LAS unsigned char*)lds_raw;
    const int bid = blockIdx.x, G = gridDim.x;
    if constexpr (PH == 0) p0_prologue(a, lds, bid, G);
    if constexpr (PH == 1) { p1_transposes(a, lds, bid, G); p1_norm(a, bid, G); }
    if constexpr (PH == 2) { pg8::Gemm g{(const bf16*)a.out, (const bf16*)(a.ws + WS_WTIN), MT, NINP, D, D};
        pg8::StaticOrder S; S.init(MT, NINP, D, G, bid);
        pg8::EpiIn E{(bf16*)(a.ws + WS_ACT), (bf16*)(a.ws + WS_XBC), (float*)(a.ws + WS_DTR)};
        pg8::gemm_phase<pg8::EpiIn, pg8::StaticOrder>(lds, g, S, E); }
    if constexpr (PH == 3) p3_states(a, lds, bid, G);
    if constexpr (PH == 4) p4_scan(a, bid, G);
    if constexpr (PH == 5) p5_mix(a, lds, bid, G);
    if constexpr (PH == 6) { pg8::Gemm g{(const bf16*)(a.ws + WS_ACT) + 1024, (const bf16*)(a.ws + WS_WTOUT), MT, D, 2048, LDACT};
        pg8::SplitOrder S; S.init(G, bid);
        pg8::EpiOut E{(const float*)(a.ws + WS_MOD), (const float*)(a.ws + WS_SS), (bf16*)(a.ws + WS_DELTA), (float*)(a.ws + WS_OUTS)};
        pg8::gemm_phase<pg8::EpiOut, pg8::SplitOrder>(lds, g, S, E); }
    if constexpr (PH == 7) p7_final(a, bid, G);
}
template <int PH> static void launch_one(const Args& a, int grid, hipStream_t stream) {
    static bool init = false;
    if (!init) { (void)hipFuncSetAttribute((const void*)mk_one<PH>, hipFuncAttributeMaxDynamicSharedMemorySize, LDS_BYTES); init = true; }
    hipLaunchKernelGGL(mk_one<PH>, dim3(grid), dim3(NTHREADS), LDS_BYTES, stream, a);
}
#endif

extern "C" void kernel_launch(void* const* d_in, const int* in_sizes, int n_in, void* d_out, int out_size, void* d_ws, size_t ws_size, hipStream_t stream) {
    static int grid = 0;
    if (grid == 0) {
        if (n_in != 21 || out_size != (int)O_END || ws_size < WS_END) { fprintf(stderr, "kernel_launch: unexpected sizes n_in %d out %d ws %zu\n", n_in, out_size, ws_size); grid = -1; return; }
        int dev = 0, cus = 0, per_cu = 0;
        hipGetDevice(&dev);
        hipDeviceGetAttribute(&cus, hipDeviceAttributeMultiprocessorCount, dev);
        hipFuncSetAttribute((const void*)mk_fwd, hipFuncAttributeMaxDynamicSharedMemorySize, LDS_BYTES);
        hipOccupancyMaxActiveBlocksPerMultiprocessor(&per_cu, (const void*)mk_fwd, NTHREADS, LDS_BYTES);
        if (per_cu < 1) { fprintf(stderr, "kernel_launch: occupancy query says %d blocks per CU\n", per_cu); grid = -1; return; }
        grid = cus;
    }
    if (grid < 0) return;
    Args a{};
    for (int i = 0; i < 21; ++i) a.in[i] = (const float*)d_in[i];
    a.out = (float*)d_out; a.ws = (unsigned char*)d_ws;
#ifdef PROBE_LIST
    const int plist[] = PROBE_LIST;
    for (int ph : plist) {
        switch (ph) { case 0: launch_one<0>(a, grid, stream); break; case 1: launch_one<1>(a, grid, stream); break; case 2: launch_one<2>(a, grid, stream); break; case 3: launch_one<3>(a, grid, stream); break;
            case 4: launch_one<4>(a, grid, stream); break; case 5: launch_one<5>(a, grid, stream); break; case 6: launch_one<6>(a, grid, stream); break; default: launch_one<7>(a, grid, stream); break; }
    }
#else
    (void)hipMemsetAsync((char*)d_ws + WS_BAR, 0, XCD_BAR_WORDS * 4, stream);
    void* args[] = {&a};
    hipError_t e = hipLaunchCooperativeKernel((const void*)mk_fwd, dim3(grid), dim3(NTHREADS), args, LDS_BYTES, stream);
    if (e != hipSuccess) fprintf(stderr, "cooperative launch failed: %s\n", hipGetErrorString(e));
#endif
}
```

```cpp
#include <hip/hip_runtime.h>
#include <hip/hip_cooperative_groups.h>
#include <cstdio>
#include <cstdint>
namespace cg = cooperative_groups;


#define LAS __attribute__((address_space(3)))
typedef unsigned short bf16;
typedef short bf16x8 __attribute__((ext_vector_type(8)));
typedef float f32x4 __attribute__((ext_vector_type(4)));
typedef float f32x2 __attribute__((ext_vector_type(2)));
typedef unsigned u32x4 __attribute__((ext_vector_type(4)));
typedef unsigned u32x2 __attribute__((ext_vector_type(2)));

constexpr int D = 1024, MP = 32768, MS = 1024, MT = MP + MS;
constexpr int NSEQ = 18, NCHUNK = MT / 64;
constexpr int NIN = 7184, NINP = 7424;
constexpr int DXBC = 2048, LDACT = 3072;
constexpr float EPS = 1e-5f;
constexpr int NTHREADS = 512;
constexpr int LDS_BYTES = 147456;

constexpr size_t MiB = 1u << 20;
constexpr size_t WS_MOD = 0;
constexpr size_t WS_WTIN = 1 * MiB;
constexpr size_t WS_WTOUT = 16 * MiB;
constexpr size_t WS_SS = 20 * MiB;
constexpr size_t WS_SSF = 22 * MiB;
constexpr size_t WS_CD = 25 * MiB;
constexpr size_t WS_DTR = 26 * MiB;
constexpr size_t WS_DTV = 29 * MiB;
constexpr size_t WS_ACU = 32 * MiB;
constexpr size_t WS_BAR = 35 * MiB;
constexpr size_t WS_ACT = 36 * MiB;
constexpr size_t WS_XBC = 234 * MiB;
constexpr size_t WS_ST = 366 * MiB;
constexpr size_t WS_OUTS = WS_XBC;
constexpr size_t WS_DELTA = WS_XBC + 32 * MiB;
constexpr size_t WS_END = 498 * MiB;
constexpr int XSI_UNIT = 256 * 72, BNI_UNIT = 64 * 136;
constexpr size_t BNI_OFF = 80 * MiB;
constexpr int NRUN = 256;
constexpr size_t RA_OFF = 116 * MiB;
constexpr size_t WS_RD = 25 * MiB + 64 * 1024;
constexpr size_t WS_CDP = 25 * MiB + 128 * 1024;

#define NT_ST(ptr, val) __builtin_nontemporal_store((val), (ptr))
#define NT_LD(ptr) __builtin_nontemporal_load(ptr)
__device__ __forceinline__ unsigned cvt_pk_bf16(float lo, float hi) { unsigned r; asm volatile("v_cvt_pk_bf16_f32 %0, %1, %2" : "=v"(r) : "v"(lo), "v"(hi)); return r; }
__device__ __forceinline__ float bf2f(unsigned b) { return __uint_as_float(b << 16); }
__device__ __forceinline__ float bflo(unsigned w) { return __uint_as_float(w << 16); }
__device__ __forceinline__ float bfhi(unsigned w) { return __uint_as_float(w & 0xffff0000u); }
__device__ __forceinline__ float silu_f(float v) { return v * __builtin_amdgcn_rcpf(1.f + __expf(-v)); }
__device__ __forceinline__ float wave_sum(float v) {
#pragma unroll
    for (int o = 1; o < 64; o <<= 1) v += __shfl_xor(v, o);
    return v;
}
__device__ __forceinline__ int seq_of_row(int row) { return row < MP ? (row >> 14) : 2 + ((row - MP) >> 6); }

namespace pg8 {
constexpr int BM = 256, BK = 64, HALF = 128, HTB = HALF * BK * 2, STAGE_BYTES = 8 * HTB, NXCD = 8, WGM = 8;
__host__ __device__ __forceinline__ int lds_byte(int r, int c) { const int st = (r >> 4) * 2 + (c >> 5), rr = r & 15, cc = c & 31, ob = rr * 64 + cc * 2; return st * 1024 + (ob ^ (((ob >> 9) & 1) << 5)); }
__host__ __device__ __forceinline__ void stage_rc(int b, int& R, int& C) { const int st = b / 1024, sb = b % 1024, swz = sb ^ (((sb >> 9) & 1) << 5); R = (st >> 1) * 16 + swz / 64; C = (st & 1) * 32 + (swz % 64) / 2; }
__host__ __device__ __forceinline__ int perm32(int rho) { const int n = rho >> 4, i = rho & 15; return 8 * (i >> 2) + 4 * n + (i & 3); }
struct Unit { int pm, pn, k0, nt; };
struct Gemm { const bf16* A; const bf16* Bt; int M, N, K, lda; };
struct StaticOrder {
    int nM, nN, nwg, G, c, ntf;
    __device__ void init(int M, int N, int K, int G_, int c_) { nM = M / BM; nN = N / BM; nwg = nM * nN; G = G_; c = c_; ntf = K / BK; }
    __device__ bool next(int i, Unit& u) const {
        const long L = (long)i * G + c; if (L >= nwg) return false;
        u.k0 = 0; u.nt = ntf;
        int wgid = (int)L; { const int q = nwg / NXCD, r = nwg % NXCD, xcd = wgid % NXCD, off = wgid / NXCD; wgid = (xcd < r ? xcd * (q + 1) : r * (q + 1) + (xcd - r) * q) + off; }
        const int nig = WGM * nN, gid = wgid / nig, fm = gid * WGM, gsz = (nM - fm) < WGM ? (nM - fm) : WGM;
        u.pm = fm + ((wgid % nig) % gsz); u.pn = (wgid % nig) / gsz; return true;
    }
};

struct SplitOrder {
    StaticOrder main; int nmain, G, c;
    __device__ void init(int G_, int c_) { main.init(MP, D, 2048, G_, c_); nmain = main.nwg; G = G_; c = c_; }
    __device__ bool next(int i, Unit& u) const {
        const long L = (long)i * G + c;
        if (L < nmain) return main.next(i, u);
        const int r = (int)(L - nmain); if (r >= 128) return false;
        u.pm = MP / BM + (r >> 5); u.pn = (r & 31) >> 3; u.k0 = (r & 7) * 256; u.nt = 4; return true;
    }
};

template <class Epi, class Order>
__device__ __forceinline__ void gemm_phase(LAS unsigned char* lds, const Gemm g, const Order& S, const Epi& E) {
    int tid = threadIdx.x; asm volatile("" : "+v"(tid));
    const int wid = __builtin_amdgcn_readfirstlane(tid >> 6), lane = tid & 63, wr = wid >> 2, wc = (wid & 3) ^ (wr << 1), fr = lane & 15, fq = lane >> 4;
    const int K = g.K, lda = g.lda;
    unsigned voffA[2], voffB[2];
#pragma unroll
    for (int i = 0; i < 2; ++i) { int R, C; stage_rc(tid * 16 + i * 8192, R, C); const int Rb = Epi::PERM ? ((R & ~31) + perm32(R & 31)) : R;
        voffA[i] = (unsigned)(R * lda + C) * 2u; voffB[i] = (unsigned)(Rb * K + C) * 2u; }
    const size_t kstep = (size_t)(BK * 2);
    const size_t hstepA = (size_t)HALF * lda * 2, tstepA = 2 * hstepA;
    const size_t hstepB = (size_t)HALF * K * 2, tstepB = 2 * hstepB;
    const unsigned ldsw = (unsigned)wid * 1024u;
    const int aoff = lds_byte(wr * 64 + fr, fq * 8), boff = lds_byte(wc * 32 + fr, fq * 8);
#define PG8_SA(b, h) (((b) * 2 + (h)) * HTB)
#define PG8_SB(b, h) ((4 + (b) * 2 + (h)) * HTB)
#define PG8_STAGE(bufoff, gbase, voff) do { _Pragma("unroll") for (int _i = 0; _i < 2; ++_i) \
        __builtin_amdgcn_global_load_lds((const unsigned*)((const char*)(gbase) + (voff)[_i]), (LAS unsigned*)(lds + (bufoff) + ldsw + _i * 8192), 16, 0, 0); } while (0)
#define PG8_LDA(dst, b, h) do { _Pragma("unroll") for (int m = 0; m < 4; ++m) _Pragma("unroll") for (int k = 0; k < 2; ++k) dst[m][k] = *(const LAS bf16x8*)(lds + PG8_SA(b, h) + aoff + m * 2048 + k * 1024); } while (0)
#define PG8_LDB(dst, b, h) do { _Pragma("unroll") for (int n = 0; n < 2; ++n) _Pragma("unroll") for (int k = 0; k < 2; ++k) dst[n][k] = *(const LAS bf16x8*)(lds + PG8_SB(b, h) + boff + n * 2048 + k * 1024); } while (0)
#define PG8_MMA(ai, bj, At, Bt) do { __builtin_amdgcn_s_setprio(1); _Pragma("unroll") for (int m = 0; m < 4; ++m) _Pragma("unroll") for (int n = 0; n < 2; ++n) _Pragma("unroll") for (int k = 0; k < 2; ++k) \
        acc[ai][bj][m][n] = __builtin_amdgcn_mfma_f32_16x16x32_bf16(Bt[n][k], At[m][k], acc[ai][bj][m][n], 0, 0, 0); __builtin_amdgcn_s_setprio(0); } while (0)
#define PG8_WAIT_V(n) asm volatile("s_waitcnt vmcnt(" #n ")" ::: "memory")
#define PG8_WAIT_L(n) asm volatile("s_waitcnt lgkmcnt(" #n ")" ::: "memory")
#define PG8_BAR __builtin_amdgcn_s_barrier()
#define PG8_SCHED __builtin_amdgcn_sched_barrier(0)
    Unit cur, nxt; int ui = 0;
    if (!S.next(0, cur)) return;
    f32x4 acc[2][2][4][2];
#pragma unroll
    for (int a = 0; a < 2; ++a)
#pragma unroll
        for (int b = 0; b < 2; ++b)
#pragma unroll
            for (int m = 0; m < 4; ++m)
#pragma unroll
                for (int n = 0; n < 2; ++n) acc[a][b][m][n] = (f32x4){0.f, 0.f, 0.f, 0.f};
    bf16x8 At[4][2], B0[2][2], B1[2][2];
    const char* cA = (const char*)g.A + (size_t)cur.pm * tstepA + (size_t)cur.k0 * 2; const char* cB = (const char*)g.Bt + (size_t)cur.pn * tstepB + (size_t)cur.k0 * 2;
    PG8_STAGE(PG8_SB(0, 0), cB, voffB); PG8_STAGE(PG8_SB(0, 1), cB + hstepB, voffB); PG8_STAGE(PG8_SA(0, 0), cA, voffA); PG8_STAGE(PG8_SA(0, 1), cA + hstepA, voffA);
    if (wr == 1) PG8_BAR;
    PG8_WAIT_V(2); PG8_BAR;
    PG8_STAGE(PG8_SB(1, 0), cB + kstep, voffB); PG8_STAGE(PG8_SA(1, 0), cA + kstep, voffA); PG8_STAGE(PG8_SB(1, 1), cB + hstepB + kstep, voffB);
    PG8_WAIT_V(6); PG8_BAR;
    for (;;) {
        const bool has_next = S.next(ui + 1, nxt);
        const char* nA = has_next ? (const char*)g.A + (size_t)nxt.pm * tstepA + (size_t)nxt.k0 * 2 : cA; const char* nB = has_next ? (const char*)g.Bt + (size_t)nxt.pn * tstepB + (size_t)nxt.k0 * 2 : cB;
        const int nt = cur.nt;
        for (int t = 0; t < nt; t += 2) {
            const bool last = (t == nt - 2);
            const char* a1 = cA + (size_t)(t + 1) * kstep;
            const char* a2 = last ? nA : cA + (size_t)(t + 2) * kstep; const char* b2 = last ? nB : cB + (size_t)(t + 2) * kstep;
            const char* a3 = a2 + kstep; const char* b3 = b2 + kstep;
            if constexpr (Epi::HAS_MID) { if (t == 16 && nt == 32) E.mid(acc, cur, wr, fr); }
            PG8_LDB(B0, 0, 0); PG8_LDB(B1, 0, 1); PG8_SCHED; PG8_LDA(At, 0, 0); PG8_STAGE(PG8_SA(1, 1), a1 + hstepA, voffA);
            PG8_WAIT_V(8); PG8_WAIT_L(0); PG8_BAR; PG8_MMA(0, 0, At, B0); PG8_MMA(0, 1, At, B1); PG8_BAR; PG8_SCHED;
            PG8_LDA(At, 0, 1); PG8_STAGE(PG8_SB(0, 0), b2, voffB); PG8_STAGE(PG8_SB(0, 1), b2 + hstepB, voffB); PG8_STAGE(PG8_SA(0, 0), a2, voffA);
            PG8_WAIT_V(8); PG8_WAIT_L(0); PG8_BAR; PG8_MMA(1, 0, At, B0); PG8_MMA(1, 1, At, B1); PG8_BAR; PG8_SCHED;
            PG8_LDB(B0, 1, 0); PG8_LDB(B1, 1, 1); PG8_SCHED; PG8_LDA(At, 1, 0); PG8_STAGE(PG8_SA(0, 1), a2 + hstepA, voffA);
            PG8_WAIT_V(8); PG8_WAIT_L(0); PG8_BAR; PG8_MMA(0, 0, At, B0); PG8_MMA(0, 1, At, B1); PG8_BAR; PG8_SCHED;
            PG8_LDA(At, 1, 1); PG8_STAGE(PG8_SB(1, 0), b3, voffB); PG8_STAGE(PG8_SB(1, 1), b3 + hstepB, voffB); PG8_STAGE(PG8_SA(1, 0), a3, voffA);
            PG8_WAIT_V(8); PG8_WAIT_L(0); PG8_BAR; PG8_MMA(1, 0, At, B0); PG8_MMA(1, 1, At, B1); PG8_BAR; PG8_SCHED;
        }
        if (wr == 0) PG8_BAR;
        E(acc, cur, wr, wc, fr, fq);
        if (!has_next) break;
#pragma unroll
        for (int a = 0; a < 2; ++a)
#pragma unroll
            for (int b = 0; b < 2; ++b)
#pragma unroll
                for (int m = 0; m < 4; ++m)
#pragma unroll
                    for (int n = 0; n < 2; ++n) acc[a][b][m][n] = (f32x4){0.f, 0.f, 0.f, 0.f};
        cur = nxt; cA = nA; cB = nB; ++ui;
        if (wr == 1) PG8_BAR;
    }
    PG8_WAIT_V(0);
    PG8_BAR;
#undef PG8_SA
#undef PG8_SB
#undef PG8_STAGE
#undef PG8_LDA
#undef PG8_LDB
#undef PG8_MMA
#undef PG8_WAIT_V
#undef PG8_WAIT_L
#undef PG8_BAR
#undef PG8_SCHED
}

struct EpiIn {
    static constexpr bool PERM = true, HAS_MID = false;
    bf16* ACT; bf16* XBC; float* DTR;
    __device__ __forceinline__ void operator()(const f32x4 (&acc)[2][2][4][2], const Unit& u, int wr, int wc, int fr, int fq) const {
        const int row0 = u.pm * BM + wr * 64 + fr;
        if (u.pn < 16) {
            bf16* base = ACT + (wc < 2 ? 0 : 1024) + 64 * u.pn + 32 * (wc & 1) + 8 * fq;
#pragma unroll
            for (int ai = 0; ai < 2; ++ai)
#pragma unroll
                for (int m = 0; m < 4; ++m) {
                    const f32x4 a0 = acc[ai][0][m][0], a1 = acc[ai][0][m][1], b0 = acc[ai][1][m][0], b1 = acc[ai][1][m][1];
                    f32x4 v0, v1;
                    if (wc < 2) { v0 = a0 * b0; v1 = a1 * b1; }
                    else {
#pragma unroll
                        for (int j = 0; j < 4; ++j) { v0[j] = a0[j] * silu_f(b0[j]); v1[j] = a1[j] * silu_f(b1[j]); }
                    }
                    u32x4 w; w.x = cvt_pk_bf16(v0[0], v0[1]); w.y = cvt_pk_bf16(v0[2], v0[3]); w.z = cvt_pk_bf16(v1[0], v1[1]); w.w = cvt_pk_bf16(v1[2], v1[3]);
                    *(u32x4*)(base + (size_t)(row0 + ai * HALF + m * 16) * LDACT) = w;
                }
        } else if (u.pn < 28) {
            bf16* base; int ld;
            if (u.pn < 20) { base = ACT + 2048 + (u.pn - 16) * 256 + 32 * wc + 8 * fq; ld = LDACT; }
            else { base = XBC + (u.pn - 20) * 256 + 32 * wc + 8 * fq; ld = DXBC; }
#pragma unroll
            for (int ai = 0; ai < 2; ++ai)
#pragma unroll
                for (int m = 0; m < 4; ++m) {
                    bf16* rowp = base + (size_t)(row0 + ai * HALF + m * 16) * ld;
#pragma unroll
                    for (int bj = 0; bj < 2; ++bj) {
                        const f32x4 v0 = acc[ai][bj][m][0], v1 = acc[ai][bj][m][1];
                        u32x4 w; w.x = cvt_pk_bf16(v0[0], v0[1]); w.y = cvt_pk_bf16(v0[2], v0[3]); w.z = cvt_pk_bf16(v1[0], v1[1]); w.w = cvt_pk_bf16(v1[2], v1[3]);
                        *(u32x4*)(rowp + bj * HALF) = w;
                    }
                }
        } else {
            if (wc == 0 && fq < 2) {
#pragma unroll
                for (int ai = 0; ai < 2; ++ai)
#pragma unroll
                    for (int m = 0; m < 4; ++m) {
                        float* p = DTR + (size_t)(row0 + ai * HALF + m * 16) * 16 + 8 * fq;
                        *(f32x4*)p = acc[ai][0][m][0]; *(f32x4*)(p + 4) = acc[ai][0][m][1];
                    }
            }
        }
    }
};

struct EpiOut {
    static constexpr bool PERM = true, HAS_MID = true;
    const float* MOD; const float* SS; bf16* DELTA; float* OUTS;
    __device__ __forceinline__ void mid(f32x4 (&acc)[2][2][4][2], const Unit& u, int wr, int fr) const {
        int rbase = u.pm * BM + wr * 64 + fr;
        asm volatile("" : "+v"(rbase));
#pragma unroll
        for (int ai = 0; ai < 2; ++ai)
#pragma unroll
            for (int m = 0; m < 4; ++m) {
                const int row = rbase + ai * HALF + m * 16;
                const f32x4 sa = *(const f32x4*)(SS + (size_t)row * 8), sb = *(const f32x4*)(SS + (size_t)row * 8 + 4);
                const float va = (sa[0] + sa[1]) + (sa[2] + sa[3]), vb = (sb[0] + sb[1]) + (sb[2] + sb[3]);
                const float tb = vb * (1.f / 1024.f) + EPS;
                const float ratio = rsqrtf(va * (1.f / 1024.f) + EPS) * (tb * rsqrtf(tb));
#pragma unroll
                for (int bj = 0; bj < 2; ++bj)
#pragma unroll
                    for (int n = 0; n < 2; ++n) acc[ai][bj][m][n] *= ratio;
                __builtin_amdgcn_sched_barrier(0);
            }
    }
    __device__ __forceinline__ void operator()(const f32x4 (&acc)[2][2][4][2], const Unit& u, int wr, int wc, int fr, int fq) const {
        const int col0 = u.pn * BM + wc * 32 + 8 * fq;
        if (u.nt != 32) {
#pragma unroll
            for (int ai = 0; ai < 2; ++ai)
#pragma unroll
                for (int m = 0; m < 4; ++m) {
                    const int row = u.pm * BM + ai * HALF + wr * 64 + m * 16 + fr;
                    const f32x4 sv = *(const f32x4*)(SS + (size_t)row * 8 + (u.k0 < 1024 ? 0 : 4));
                    const float rs = rsqrtf(((sv[0] + sv[1]) + (sv[2] + sv[3])) * (1.f / 1024.f) + EPS);
                    float* op = OUTS + ((size_t)(u.k0 >> 8) * MS + (row - MP)) * D + col0;
#pragma unroll
                    for (int bj = 0; bj < 2; ++bj)
#pragma unroll
                        for (int n = 0; n < 2; ++n) *(f32x4*)(op + bj * HALF + n * 4) = acc[ai][bj][m][n] * rs;
                }
            return;
        }
        const float* gp = MOD + (u.pm >> 6) * 3072 + 2048 + col0;
        f32x4 gv[2][2];
#pragma unroll
        for (int bj = 0; bj < 2; ++bj)
#pragma unroll
            for (int n = 0; n < 2; ++n) gv[bj][n] = *(const f32x4*)(gp + bj * HALF + n * 4);
#pragma unroll
        for (int ai = 0; ai < 2; ++ai)
#pragma unroll
            for (int m = 0; m < 4; ++m) {
                const int row = u.pm * BM + ai * HALF + wr * 64 + m * 16 + fr;
                const f32x4 sb = *(const f32x4*)(SS + (size_t)row * 8 + 4);
                const float rb = rsqrtf(((sb[0] + sb[1]) + (sb[2] + sb[3])) * (1.f / 1024.f) + EPS);
                bf16* op = DELTA + (size_t)row * D + col0;
#pragma unroll
                for (int bj = 0; bj < 2; ++bj) {
                    const f32x4 v0 = gv[bj][0] * (acc[ai][bj][m][0] * rb), v1 = gv[bj][1] * (acc[ai][bj][m][1] * rb);
                    u32x4 w; w.x = cvt_pk_bf16(v0[0], v0[1]); w.y = cvt_pk_bf16(v0[2], v0[3]); w.z = cvt_pk_bf16(v1[0], v1[1]); w.w = cvt_pk_bf16(v1[2], v1[3]);
                    *(u32x4*)(op + bj * HALF) = w;
                }
            }
    }
};
}

struct Args {
    const float* in[21]; float* out; unsigned char* ws; int pad0, pad1;
};
enum { I_XP = 0, I_XS, I_SCA, I_SCB, I_SSM, I_CP, I_CS, I_WMOD, I_BMOD, I_NIN, I_WIN, I_CAW, I_NAW, I_CBW, I_CBB, I_DTB, I_ALOG, I_DSKIP, I_NBW, I_WOUT, I_NFW };
constexpr size_t O_Y = 0, O_CAP = 34603008, O_CBP = 34607104, O_SSMP = 34619392, O_CAS = 34881536, O_CBS = 34914304, O_SSMS = 35012608, O_END = 37109760;

__device__ __forceinline__ int in_srccol(int n) {
    if (n < 4096) { const int w = n & 255, seg = w >> 6, j = (n >> 8) * 64 + (w & 63); const int off = seg == 0 ? 1024 : (seg == 1 ? 0 : (seg == 2 ? 2048 : 3072)); return off + j; }
    return n < NIN ? n : -1;
}
template <bool IN>
__device__ __forceinline__ void p0_transpose_item(const float* W, int K, int Nsrc, bf16* WT, LAS float* scr, int k0, int n0, int lane) {
    const int nd = n0 + (lane & 31); const int src = IN ? in_srccol(nd) : nd;
#pragma unroll
    for (int i = 0; i < 32; ++i) { const int kk = 2 * i + (lane >> 5); scr[kk * 33 + (lane & 31)] = src >= 0 ? W[(size_t)(k0 + kk) * Nsrc + src] : 0.f; }
    asm volatile("s_waitcnt lgkmcnt(0)" ::: "memory");
    const int c = lane & 7;
#pragma unroll
    for (int j = 0; j < 4; ++j) { const int n = (lane >> 3) + 8 * j; const LAS float* s = scr + (8 * c) * 33 + n;
        u32x4 o; o.x = cvt_pk_bf16(s[0 * 33], s[1 * 33]); o.y = cvt_pk_bf16(s[2 * 33], s[3 * 33]); o.z = cvt_pk_bf16(s[4 * 33], s[5 * 33]); o.w = cvt_pk_bf16(s[6 * 33], s[7 * 33]);
        *(u32x4*)(WT + (size_t)(n0 + n) * K + k0 + 8 * c) = o; }
    asm volatile("s_waitcnt lgkmcnt(0)" ::: "memory");
}

__device__ __forceinline__ void p0_prologue(const Args& a, LAS unsigned char* lds, int bid, int G) {
    int tid = threadIdx.x; asm volatile("" : "+v"(tid));

    for (int item = bid; item < 192; item += G) {
        LAS float* cl = (LAS float*)lds;
        LAS float* red = (LAS float*)(lds + 73728);
        for (int i = tid; i < NSEQ * 1024 / 4; i += NTHREADS) ((LAS f32x4*)cl)[i] = i < 512 ? ((const f32x4*)a.in[I_CP])[i] : ((const f32x4*)a.in[I_CS])[i - 512];
        const int col = tid & 15, kg = tid >> 4, j0 = item * 16;
        const float* wm = a.in[I_WMOD] + (size_t)(kg * 32) * 3072 + j0 + col;
        float w[32];
#pragma unroll
        for (int kk = 0; kk < 32; ++kk) w[kk] = wm[(size_t)kk * 3072];
        __syncthreads();
        float acc[NSEQ];
#pragma unroll
        for (int s = 0; s < NSEQ; ++s) acc[s] = 0.f;
#pragma unroll
        for (int k4 = 0; k4 < 8; ++k4) {
#pragma unroll
            for (int s = 0; s < NSEQ; ++s) { const f32x4 c4 = *(const LAS f32x4*)(cl + s * 1024 + kg * 32 + 4 * k4);
                acc[s] += (c4[0] * w[4 * k4] + c4[1] * w[4 * k4 + 1]) + (c4[2] * w[4 * k4 + 2] + c4[3] * w[4 * k4 + 3]); }
        }
#pragma unroll
        for (int s = 0; s < NSEQ; ++s) red[(kg * NSEQ + s) * 16 + col] = acc[s];
        __syncthreads();
        for (int o = tid; o < NSEQ * 16; o += NTHREADS) { const int s = o >> 4, c = o & 15; float v = a.in[I_BMOD][j0 + c];
#pragma unroll
            for (int k2 = 0; k2 < 32; ++k2) v += red[(k2 * NSEQ + s) * 16 + c];
            ((float*)(a.ws + WS_MOD))[s * 3072 + j0 + c] = v; }
        __syncthreads();
    }
}
__device__ __forceinline__ void p1_transposes(const Args& a, LAS unsigned char* lds, int bid, int G) {
    int tid = threadIdx.x; asm volatile("" : "+v"(tid));
    const int lane = tid & 63, wave = tid >> 6;
    LAS float* scr = (LAS float*)(lds + wave * 16384);
    const int gw = bid * 8 + wave, NGW = G * 8;
    constexpr int I_IN = (NINP / 32) * (D / 64), I_OUT = (D / 32) * (2048 / 64);
    for (int it = gw; it < I_IN + I_OUT; it += NGW) {
        if (it < I_IN) { const int nb = it / (D / 64), kb = it % (D / 64); p0_transpose_item<true>(a.in[I_WIN], D, NIN, (bf16*)(a.ws + WS_WTIN), scr, kb * 64, nb * 32, lane); }
        else { const int r = it - I_IN; const int nb = r / 32, kb = r % 32; p0_transpose_item<false>(a.in[I_WOUT], 2048, D, (bf16*)(a.ws + WS_WTOUT), scr, kb * 64, nb * 32, lane); }
    }
}

__device__ __forceinline__ void p1_norm(const Args& a, int bid, int G) {
    int tid = threadIdx.x; asm volatile("" : "+v"(tid));
    const int lane = tid & 63, wave = tid >> 6;
    const float* MOD = (const float*)(a.ws + WS_MOD); bf16* H = (bf16*)a.out;
    f32x4 nw[4];
#pragma unroll
    for (int j = 0; j < 4; ++j) nw[j] = ((const f32x4*)a.in[I_NIN])[lane + 64 * j];
    for (int row = bid * 8 + wave; row < MT; row += G * 8) {
        const f32x4* xr = (const f32x4*)(row < MP ? a.in[I_XP] + (size_t)row * D : a.in[I_XS] + (size_t)(row - MP) * D);
        const int s = seq_of_row(row);
        f32x4 v[4]; float ss = 0.f;
#pragma unroll
        for (int j = 0; j < 4; ++j) { v[j] = NT_LD(xr + lane + 64 * j); ss += (v[j][0] * v[j][0] + v[j][1] * v[j][1]) + (v[j][2] * v[j][2] + v[j][3] * v[j][3]); }
        const float rstd = rsqrtf(wave_sum(ss) * (1.f / D) + EPS);
        const f32x4* sh = (const f32x4*)(MOD + s * 3072); const f32x4* sc = (const f32x4*)(MOD + s * 3072 + 1024);
        u32x2* o = (u32x2*)(H + (size_t)row * D);
#pragma unroll
        for (int j = 0; j < 4; ++j) { const f32x4 h = v[j] * rstd * nw[j] * (sc[lane + 64 * j] + 1.f) + sh[lane + 64 * j];
            u32x2 w; w.x = cvt_pk_bf16(h[0], h[1]); w.y = cvt_pk_bf16(h[2], h[3]); o[lane + 64 * j] = w; }
    }
}

__device__ __forceinline__ u32x4 pack8(const float (&v)[8]) { u32x4 w; w.x = cvt_pk_bf16(v[0], v[1]); w.y = cvt_pk_bf16(v[2], v[3]); w.z = cvt_pk_bf16(v[4], v[5]); w.w = cvt_pk_bf16(v[6], v[7]); return w; }
__device__ __forceinline__ float rawel(const u32x4& w, int c) { const unsigned x = w[c >> 1]; return (c & 1) ? bfhi(x) : bflo(x); }
__device__ __forceinline__ void conv_load(const bf16* XBC, const float* stb, int cidx, int xcol, int rs, u32x4 (&r)[11]) {
    const bf16* p = XBC + (size_t)(cidx * 64 + 8 * rs - 3) * DXBC + xcol;
#pragma unroll
    for (int k = 3; k < 11; ++k) r[k] = *(const u32x4*)(p + (size_t)k * DXBC);
    if (rs > 0 || (cidx < 512 && (cidx & 255) != 0)) {
#pragma unroll
        for (int k = 0; k < 3; ++k) r[k] = *(const u32x4*)(p + (size_t)k * DXBC);
    } else if (cidx >= 512) {
        const float* s = stb + (size_t)(cidx - 512) * 3 * DXBC + xcol;
#pragma unroll
        for (int k = 0; k < 3; ++k) { const f32x4 a0 = *(const f32x4*)(s + k * DXBC), a1 = *(const f32x4*)(s + k * DXBC + 4);
            r[k].x = cvt_pk_bf16(a0[0], a0[1]); r[k].y = cvt_pk_bf16(a0[2], a0[3]); r[k].z = cvt_pk_bf16(a1[0], a1[1]); r[k].w = cvt_pk_bf16(a1[2], a1[3]); }
    } else {
#pragma unroll
        for (int k = 0; k < 3; ++k) r[k] = (u32x4){0u, 0u, 0u, 0u};
    }
}
struct ConvW { f32x4 w[4][2]; f32x4 b[2]; };
__device__ __forceinline__ void convw_load(const float* cw, const float* cb, int xcol, ConvW& W) {
#pragma unroll
    for (int j = 0; j < 4; ++j) { W.w[j][0] = *(const f32x4*)(cw + j * DXBC + xcol); W.w[j][1] = *(const f32x4*)(cw + j * DXBC + xcol + 4); }
    W.b[0] = *(const f32x4*)(cb + xcol); W.b[1] = *(const f32x4*)(cb + xcol + 4);
}
__device__ __forceinline__ float conv_el(const u32x4 (&r)[11], const ConvW& W, int t, int c) {
    const float v = W.b[c >> 2][c & 3] + W.w[0][c >> 2][c & 3] * rawel(r[t], c) + W.w[1][c >> 2][c & 3] * rawel(r[t + 1], c) + W.w[2][c >> 2][c & 3] * rawel(r[t + 2], c) + W.w[3][c >> 2][c & 3] * rawel(r[t + 3], c);
    return silu_f(v);
}
__device__ __forceinline__ float softplus_f(float x) { return x > 20.f ? x : log1pf(__expf(x)); }

#define WG_BAR() do { asm volatile("s_waitcnt lgkmcnt(0)" ::: "memory"); __builtin_amdgcn_s_barrier(); asm volatile("" ::: "memory"); } while (0)
__device__ __forceinline__ void p3_states(const Args& a, LAS unsigned char* lds, int bid, int G) {
    int tid = threadIdx.x; asm volatile("" : "+v"(tid));
    const int lane = tid & 63, wave = __builtin_amdgcn_readfirstlane(tid >> 6), fr = lane & 15, fq = lane >> 4;
    const bf16* XBC = (const bf16*)(a.ws + WS_XBC); const float* DTR = (const float*)(a.ws + WS_DTR);
    float* DTV = (float*)(a.ws + WS_DTV); float* ACU = (float*)(a.ws + WS_ACU); float* CD = (float*)(a.ws + WS_CD);
    bf16* ST = (bf16*)(a.ws + WS_ST);
    LAS float* dtw2 = (LAS float*)lds; LAS float* cdl2 = (LAS float*)(lds + 2048);
    bf16* XSI = (bf16*)a.out; bf16* BNI = (bf16*)((unsigned char*)a.out + BNI_OFF);
    const int rs = lane & 7, cg = 8 * wave + (lane >> 3);
    bf16* RA = (bf16*)((unsigned char*)a.out + RA_OFF); float* RD = (float*)(a.ws + WS_RD); float* CDP = (float*)(a.ws + WS_CDP);
#define P3_DT(CIDX, GG, BUF, DTRAW) do { if (wave < 4) { const int cidx_ = (CIDX), h_ = 4 * (GG) + wave, row_ = cidx_ * 64 + lane; \
        const float dt = softplus_f((DTRAW) + a.in[I_DTB][h_]); const float da = dt * -__expf(a.in[I_ALOG][h_]); float ac = da; \
        _Pragma("unroll") for (int o = 1; o < 64; o <<= 1) { const float t = __shfl_up(ac, o); if (lane >= o) ac += t; } \
        const float tot = __shfl(ac, 63); \
        dtw2[(BUF) * 256 + lane * 4 + wave] = dt * __expf(tot - ac); \
        DTV[(size_t)row_ * 16 + h_] = dt; ACU[(size_t)row_ * 16 + h_] = ac; \
        if (lane == 63) { const float cdv = __expf(tot); CD[cidx_ * 16 + h_] = cdv; cdl2[(BUF) * 4 + wave] = cdv; } } } while (0)
    for (int rho = bid; rho < NRUN + 64; rho += G) {
      const bool samp = rho >= NRUN;
      const int g = samp ? ((rho - NRUN) & 3) : ((rho >> 5) & 3);
      const int cbase = samp ? 512 + ((rho - NRUN) >> 2) : (rho >> 7) * 256 + (rho & 31) * 8;
      const int nci = samp ? 1 : 8;
      f32x4 acc[4][4];
#pragma unroll
      for (int i = 0; i < 4; ++i)
#pragma unroll
          for (int j = 0; j < 4; ++j) acc[i][j] = (f32x4){0.f, 0.f, 0.f, 0.f};
      float cum = 1.f;
      __syncthreads();
      LAS float* cwl = (LAS float*)(lds + 59392);
      for (int i = tid; i < 5 * 384; i += NTHREADS) { const int j = i / 384, col = i - j * 384; const int xc = col < 256 ? 256 * g + col : 1024 + 128 * g + (col - 256);
          cwl[i] = j < 4 ? a.in[I_CBW][j * DXBC + xc] : a.in[I_CBB][xc]; }
      { const float d0 = DTR[(size_t)(cbase * 64 + lane) * 16 + 4 * g + (wave & 3)]; P3_DT(cbase, g, 0, d0); }
      __syncthreads();
#pragma unroll 1
      for (int ci = 0; ci < nci; ++ci) {
        const int cidx = cbase + ci, unit = cidx * 4 + g, row0 = cidx * 64;
        u32x4 r[11];
        const int xcol = cg < 32 ? 256 * g + 8 * cg : 1024 + 128 * g + 8 * (cg - 32);
        if (wave < 6) conv_load(XBC, a.in[I_SCB], cidx, xcol, rs, r);
        const int pb = ci & 1;
        LAS bf16* xsT = (LAS bf16*)(lds + (pb ? 67584 : 4096)); LAS bf16* BT = (LAS bf16*)(lds + (pb ? 104448 : 40960));
        const float dnext = DTR[(size_t)((ci + 1 < nci ? cidx + 1 : cidx) * 64 + lane) * 16 + 4 * g + (wave & 3)];
        if (wave < 6 && rs == 7 && (cidx >= 512 || (cidx & 255) == 255)) {
            float* op = cidx >= 512 ? a.out + O_CBS + (size_t)(cidx - 512) * 3 * DXBC + xcol : a.out + O_CBP + (size_t)(cidx >> 8) * 3 * DXBC + xcol;
#pragma unroll
            for (int k = 0; k < 3; ++k) { *(f32x4*)(op + k * DXBC) = (f32x4){rawel(r[8 + k], 0), rawel(r[8 + k], 1), rawel(r[8 + k], 2), rawel(r[8 + k], 3)};
                *(f32x4*)(op + k * DXBC + 4) = (f32x4){rawel(r[8 + k], 4), rawel(r[8 + k], 5), rawel(r[8 + k], 6), rawel(r[8 + k], 7)}; }
        }
        if (wave < 4) {
            LAS bf16* dst = xsT + (8 * cg) * 72 + 8 * rs;
            bf16* gi = XSI + (size_t)unit * XSI_UNIT + (8 * cg) * 72 + 8 * rs;
            float sc[8];
#pragma unroll
            for (int t = 0; t < 8; ++t) sc[t] = dtw2[pb * 256 + (8 * rs + t) * 4 + wave];
#pragma unroll
            for (int c = 0; c < 8; ++c) {
                float o[8]; const LAS float* wp = cwl + 8 * cg + c;
                const float w0 = wp[0], w1 = wp[384], w2 = wp[768], w3 = wp[1152], wb = wp[1536];
#pragma unroll
                for (int t = 0; t < 8; ++t) o[t] = silu_f(wb + w0 * rawel(r[t], c) + w1 * rawel(r[t + 1], c) + w2 * rawel(r[t + 2], c) + w3 * rawel(r[t + 3], c));
                *(u32x4*)(gi + c * 72) = pack8(o);
#pragma unroll
                for (int t = 0; t < 8; ++t) o[t] *= sc[t];
                *(LAS u32x4*)(dst + c * 72) = pack8(o);
            }
        } else if (wave < 6) {
            LAS bf16* dst = BT + (8 * (cg - 32)) * 72 + 8 * rs;
            bf16* gi = BNI + (size_t)unit * BNI_UNIT + (8 * rs) * 136 + 8 * (cg - 32);
            u32x4 rowpk[8];
#pragma unroll
            for (int c2 = 0; c2 < 4; ++c2) {
                float o0[8], o1[8]; const LAS float* wp = cwl + 8 * cg + 2 * c2;
                const float w0 = wp[0], w1 = wp[384], w2 = wp[768], w3 = wp[1152], wb = wp[1536], v0 = wp[1], v1 = wp[385], v2 = wp[769], v3 = wp[1153], vb = wp[1537];
#pragma unroll
                for (int t = 0; t < 8; ++t) { o0[t] = silu_f(wb + w0 * rawel(r[t], 2 * c2) + w1 * rawel(r[t + 1], 2 * c2) + w2 * rawel(r[t + 2], 2 * c2) + w3 * rawel(r[t + 3], 2 * c2));
                    o1[t] = silu_f(vb + v0 * rawel(r[t], 2 * c2 + 1) + v1 * rawel(r[t + 1], 2 * c2 + 1) + v2 * rawel(r[t + 2], 2 * c2 + 1) + v3 * rawel(r[t + 3], 2 * c2 + 1)); }
                *(LAS u32x4*)(dst + (2 * c2) * 72) = pack8(o0); *(LAS u32x4*)(dst + (2 * c2 + 1) * 72) = pack8(o1);
#pragma unroll
                for (int t = 0; t < 8; ++t) rowpk[t][c2] = cvt_pk_bf16(o0[t], o1[t]);
            }
#pragma unroll
            for (int t = 0; t < 8; ++t) *(u32x4*)(gi + t * 136) = rowpk[t];
        }
        __syncthreads();
        {
            const int hl = wave >> 1, nh = wave & 1, h = 4 * g + hl;
            const float cdv = cdl2[pb * 4 + hl];
            if (!samp) {
                if (ci > 0) {
                bf16* sp = ST + ((size_t)cidx * 16 + h) * 8192;
#pragma unroll
                for (int i = 0; i < 4; ++i)
#pragma unroll
                    for (int j = 0; j < 4; ++j) { u32x2 w; w.x = cvt_pk_bf16(acc[i][j][0], acc[i][j][1]); w.y = cvt_pk_bf16(acc[i][j][2], acc[i][j][3]);
                        *(u32x2*)(sp + (16 * j + fr) * 128 + 64 * nh + 16 * i + 4 * fq) = w; }
                }
                if (nh == 0 && lane == 0) CDP[cidx * 16 + h] = cum;
#pragma unroll
                for (int i = 0; i < 4; ++i)
#pragma unroll
                    for (int j = 0; j < 4; ++j) acc[i][j] *= cdv;
                cum *= cdv;
            }
#pragma unroll
            for (int ks = 0; ks < 2; ++ks) {
                bf16x8 xf[4], yf[4];
#pragma unroll
                for (int i = 0; i < 4; ++i) xf[i] = *(const LAS bf16x8*)(BT + (64 * nh + 16 * i + fr) * 72 + 32 * ks + 8 * fq);
#pragma unroll
                for (int j = 0; j < 4; ++j) yf[j] = *(const LAS bf16x8*)(xsT + (64 * hl + 16 * j + fr) * 72 + 32 * ks + 8 * fq);
#pragma unroll
                for (int i = 0; i < 4; ++i)
#pragma unroll
                    for (int j = 0; j < 4; ++j) acc[i][j] = __builtin_amdgcn_mfma_f32_16x16x32_bf16(xf[i], yf[j], acc[i][j], 0, 0, 0);
            }
            if (samp) {
                const int b = cidx - 512;
                const float* s0 = a.in[I_SSM] + ((size_t)b * 16 + h) * 8192; float* so = a.out + O_SSMS + ((size_t)b * 16 + h) * 8192;
#pragma unroll
                for (int i = 0; i < 4; ++i)
#pragma unroll
                    for (int j = 0; j < 4; ++j) { const int off = (16 * j + fr) * 128 + 64 * nh + 16 * i + 4 * fq;
                        *(f32x4*)(so + off) = *(const f32x4*)(s0 + off) * cdv + acc[i][j]; }
            }
        }
        if (ci + 1 < nci) P3_DT(cidx + 1, g, pb ^ 1, dnext);
      }
      if (!samp) {
          const int hl = wave >> 1, nh = wave & 1;
          bf16* sp = RA + ((size_t)rho * 4 + hl) * 8192;
#pragma unroll
          for (int i = 0; i < 4; ++i)
#pragma unroll
              for (int j = 0; j < 4; ++j) { u32x2 w; w.x = cvt_pk_bf16(acc[i][j][0], acc[i][j][1]); w.y = cvt_pk_bf16(acc[i][j][2], acc[i][j][3]);
                  *(u32x2*)(sp + (16 * j + fr) * 128 + 64 * nh + 16 * i + 4 * fq) = w; }
          if (nh == 0 && lane == 0) RD[rho * 4 + hl] = cum;
      }
    }
}

__device__ __forceinline__ void p4_scan(const Args& a, int bid, int G) {
    unsigned* RAw = (unsigned*)((unsigned char*)a.out + RA_OFF); const float* RD = (const float*)(a.ws + WS_RD);
    for (int idx = bid * NTHREADS + (int)threadIdx.x; idx < 8 * 16384; idx += G * NTHREADS) {
        const int sg = idx >> 14, e2 = idx & 16383, hl = e2 >> 12;
        float run0 = 0.f, run1 = 0.f;
        unsigned* p = RAw + (size_t)(sg * 32) * 16384 + e2; const float* rd = RD + (sg * 32) * 4 + hl;
        unsigned v[32]; float d[32];
#pragma unroll
        for (int k = 0; k < 32; ++k) { v[k] = p[(size_t)k * 16384]; d[k] = rd[k * 4]; }
#pragma unroll
        for (int k = 0; k < 32; ++k) { p[(size_t)k * 16384] = cvt_pk_bf16(run0, run1); run0 = run0 * d[k] + bflo(v[k]); run1 = run1 * d[k] + bfhi(v[k]); }
        *(f32x2*)(a.out + O_SSMP + (size_t)(sg >> 2) * 131072 + (size_t)(4 * (sg & 3) + hl) * 8192 + 2 * (e2 & 4095)) = (f32x2){run0, run1};
    }
}

__device__ __forceinline__ void p5_mix(const Args& a, LAS unsigned char* lds, int bid, int G) {
    int tid = threadIdx.x; asm volatile("" : "+v"(tid));
    const int lane = tid & 63, wave = __builtin_amdgcn_readfirstlane(tid >> 6), fr = lane & 15, fq = lane >> 4;
    bf16* ACT = (bf16*)(a.ws + WS_ACT); const bf16* XBC = (const bf16*)(a.ws + WS_XBC);
    const float* DTV = (const float*)(a.ws + WS_DTV); const float* ACU = (const float*)(a.ws + WS_ACU);
    const bf16* ST = (const bf16*)(a.ws + WS_ST); float* SS = (float*)(a.ws + WS_SS);
    LAS float* dtv = (LAS float*)lds; LAS float* acu = (LAS float*)(lds + 1024); LAS float* ea = (LAS float*)(lds + 2048);
    LAS float* partA = (LAS float*)(lds + 3072); LAS float* partB = (LAS float*)(lds + 3584);
    LAS bf16* xsT = (LAS bf16*)(lds + 8192); LAS bf16* Bn = (LAS bf16*)(lds + 45056); LAS bf16* Cn = (LAS bf16*)(lds + 62464); LAS bf16* Mh = (LAS bf16*)(lds + 79872);
    const bf16* XSI = (const bf16*)a.out; const bf16* BNI = (const bf16*)((const unsigned char*)a.out + BNI_OFF);
    const int tidp5_ = tid; const int cgc = tid & 15, rs2 = tid >> 4;
    u32x4 im[7], rc[5]; ConvW W; float dt_r, ac_r;
#define P5_LOADS(UNIT) do { const int u_ = (UNIT), cidx_ = u_ >> 2, q_ = u_ & 3; int tid = tidp5_; asm volatile("" : "+v"(tid));   \
        const int cgc = tid & 15, rs2 = tid >> 4, xcol_ = 1536 + 128 * q_ + 8 * cgc; \
        dt_r = DTV[(size_t)(cidx_ * 64 + ((tid & 255) >> 2)) * 16 + 4 * q_ + (tid & 3)]; ac_r = ACU[(size_t)(cidx_ * 64 + ((tid & 255) >> 2)) * 16 + 4 * q_ + (tid & 3)]; \
        const bool sample_ = cidx_ >= 512, first_ = !sample_ && (cidx_ & 255) == 0; \
        const u32x4* xi_ = (const u32x4*)(XSI + (size_t)u_ * XSI_UNIT); const u32x4* bi_ = (const u32x4*)(BNI + (size_t)u_ * BNI_UNIT); \
        _Pragma("unroll") for (int k = 0; k < 7; ++k) { const int idx = tid + NTHREADS * k; if (idx < 2304) im[k] = xi_[idx]; else if (idx < 3392) im[k] = bi_[idx - 2304]; } \
        const int tb_ = 2 * rs2 - 3; \
        _Pragma("unroll") for (int k = 0; k < 5; ++k) { const int tr = tb_ + k; \
            if (tr >= 0 || (!sample_ && !first_)) rc[k] = *(const u32x4*)(XBC + (size_t)(cidx_ * 64 + tr) * DXBC + xcol_); \
            else if (sample_) { const float* sp = a.in[I_SCB] + ((size_t)(cidx_ - 512) * 3 + (3 + tr)) * DXBC + xcol_; const f32x4 a0 = *(const f32x4*)sp, a1 = *(const f32x4*)(sp + 4); \
                rc[k].x = cvt_pk_bf16(a0[0], a0[1]); rc[k].y = cvt_pk_bf16(a0[2], a0[3]); rc[k].z = cvt_pk_bf16(a1[0], a1[1]); rc[k].w = cvt_pk_bf16(a1[2], a1[3]); } \
            else rc[k] = (u32x4){0u, 0u, 0u, 0u}; } \
        convw_load(a.in[I_CBW], a.in[I_CBB], xcol_, W); } while (0)
    if (bid < NCHUNK * 4) P5_LOADS(bid);
    for (int unit = bid; unit < NCHUNK * 4; unit += G) {
        const int cidx = unit >> 2, q = unit & 3, row0 = cidx * 64;
        const bool sample = cidx >= 512, first = !sample && (cidx & 255) == 0, lastc = sample || (cidx & 255) == 255;
        const int xcol = 1536 + 128 * q + 8 * cgc;
        if (tid < 256) { dtv[tid] = dt_r; acu[tid] = ac_r; ea[tid] = __expf(ac_r); }
#pragma unroll
        for (int k = 0; k < 7; ++k) { const int idx = tid + NTHREADS * k; if (idx < 2304) ((LAS u32x4*)xsT)[idx] = im[k]; else if (idx < 3392) ((LAS u32x4*)Bn)[idx - 2304] = im[k]; }
        if (lastc && rs2 == 31) {
            float* op = sample ? a.out + O_CBS + (size_t)(cidx - 512) * 3 * DXBC + xcol : a.out + O_CBP + (size_t)(cidx >> 8) * 3 * DXBC + xcol;
#pragma unroll
            for (int k = 0; k < 3; ++k) { *(f32x4*)(op + k * DXBC) = (f32x4){rawel(rc[2 + k], 0), rawel(rc[2 + k], 1), rawel(rc[2 + k], 2), rawel(rc[2 + k], 3)};
                *(f32x4*)(op + k * DXBC + 4) = (f32x4){rawel(rc[2 + k], 4), rawel(rc[2 + k], 5), rawel(rc[2 + k], 6), rawel(rc[2 + k], 7)}; }
        }
#pragma unroll
        for (int t = 0; t < 2; ++t) {
            float o[8];
#pragma unroll
            for (int c = 0; c < 8; ++c) {
                const float v = W.b[c >> 2][c & 3] + W.w[0][c >> 2][c & 3] * rawel(rc[t], c) + W.w[1][c >> 2][c & 3] * rawel(rc[t + 1], c) + W.w[2][c >> 2][c & 3] * rawel(rc[t + 2], c) + W.w[3][c >> 2][c & 3] * rawel(rc[t + 3], c);
                o[c] = silu_f(v);
            }
            *(LAS u32x4*)(Cn + (2 * rs2 + t) * 136 + 8 * cgc) = pack8(o);
        }
        WG_BAR();
        {
#pragma unroll 1
            for (int tt = 0; tt < 2; ++tt) {
                const int tile = wave * 2 + tt, it = tile >> 2, jt = tile & 3;
                if (jt > it) {
#pragma unroll
                    for (int hl = 0; hl < 4; ++hl) *(LAS u32x2*)(Mh + (hl * 64 + 16 * it + fr) * 72 + 16 * jt + 4 * fq) = (u32x2){0u, 0u};
                    continue;
                }
                f32x4 cb = (f32x4){0.f, 0.f, 0.f, 0.f};
#pragma unroll
                for (int ks = 0; ks < 4; ++ks) {
                    const bf16x8 xf = *(const LAS bf16x8*)(Bn + (16 * jt + fr) * 136 + 32 * ks + 8 * fq);
                    const bf16x8 yf = *(const LAS bf16x8*)(Cn + (16 * it + fr) * 136 + 32 * ks + 8 * fq);
                    cb = __builtin_amdgcn_mfma_f32_16x16x32_bf16(xf, yf, cb, 0, 0, 0);
                }
                const int i = 16 * it + fr, jb = 16 * jt + 4 * fq;
#pragma unroll
                for (int hl = 0; hl < 4; ++hl) {
                    const float ai = acu[i * 4 + hl], dsk = a.in[I_DSKIP][4 * q + hl];
                    float mv[4];
#pragma unroll
                    for (int jj = 0; jj < 4; ++jj) { const int j = jb + jj;
                        float v = (i >= j) ? cb[jj] * __expf(ai - acu[j * 4 + hl]) * dtv[j * 4 + hl] : 0.f;
                        if (i == j) v += dsk;
                        mv[jj] = v; }
                    u32x2 w; w.x = cvt_pk_bf16(mv[0], mv[1]); w.y = cvt_pk_bf16(mv[2], mv[3]);
                    *(LAS u32x2*)(Mh + (hl * 64 + i) * 72 + jb) = w;
                }
            }
        }
        WG_BAR();
            const int ca = lane & 31, ra = 2 * wave + (lane >> 5), ja = 256 * q + 8 * ca, ta = 4 * ra;
            u32x4 ur[6], br[4];
        {
            const int hl = wave >> 1, ph = wave & 1, h = 4 * q + hl;
            float ssqa[4] = {0.f, 0.f, 0.f, 0.f};
            const bool haslp = sample || (cidx & 7) != 0;
#pragma unroll 1
            for (int ptl = 0; ptl < 2; ++ptl) {
                const int p0 = 32 * ph + 16 * ptl;
                bf16x8 sf[4], lf[4]; float cdp = 0.f;
                if (!sample) {
                    const int rho = ((cidx >> 8) * 4 + q) * 32 + ((cidx & 255) >> 3);
                    const bf16* sr = (const bf16*)((const unsigned char*)a.out + RA_OFF) + ((size_t)rho * 4 + hl) * 8192 + (p0 + fr) * 128 + 8 * fq;
                    const bf16* sp = ST + ((size_t)cidx * 16 + h) * 8192 + (p0 + fr) * 128 + 8 * fq;
#pragma unroll
                    for (int ks = 0; ks < 4; ++ks) { sf[ks] = *(const bf16x8*)(sr + 32 * ks); if (haslp) lf[ks] = *(const bf16x8*)(sp + 32 * ks); }
                    cdp = ((const float*)(a.ws + WS_CDP))[cidx * 16 + h];
                } else {
                    const float* sp = a.in[I_SSM] + ((size_t)(cidx - 512) * 16 + h) * 8192 + (p0 + fr) * 128 + 8 * fq;
#pragma unroll
                    for (int ks = 0; ks < 4; ++ks) { const f32x4 v0 = *(const f32x4*)(sp + 32 * ks), v1 = *(const f32x4*)(sp + 32 * ks + 4);
                        u32x4 w; w.x = cvt_pk_bf16(v0[0], v0[1]); w.y = cvt_pk_bf16(v0[2], v0[3]); w.z = cvt_pk_bf16(v1[0], v1[1]); w.w = cvt_pk_bf16(v1[2], v1[3]);
                        lf[ks] = __builtin_bit_cast(bf16x8, w); }
                }
                bf16* zp0 = ACT + (size_t)(row0 + fr) * LDACT + 2048 + 256 * q + 64 * hl + p0 + 4 * fq;
                u32x2 zw[4];
#pragma unroll
                for (int il = 0; il < 4; ++il) zw[il] = *(const u32x2*)(zp0 + (size_t)(16 * il) * LDACT);
                const f32x4 nw4 = *(const f32x4*)(a.in[I_NBW] + 256 * q + 64 * hl + p0 + 4 * fq);
                f32x4 ad[4], ao[4];
#pragma unroll
                for (int il = 0; il < 4; ++il) { ad[il] = (f32x4){0.f, 0.f, 0.f, 0.f}; ao[il] = (f32x4){0.f, 0.f, 0.f, 0.f}; }
#pragma unroll
                for (int ks = 0; ks < 2; ++ks) {
                    const bf16x8 xf = *(const LAS bf16x8*)(xsT + (64 * hl + p0 + fr) * 72 + 32 * ks + 8 * fq);
#pragma unroll
                    for (int il = 0; il < 4; ++il) ad[il] = __builtin_amdgcn_mfma_f32_16x16x32_bf16(xf, *(const LAS bf16x8*)(Mh + (hl * 64 + 16 * il + fr) * 72 + 32 * ks + 8 * fq), ad[il], 0, 0, 0);
                }
                f32x4 aos[4];
#pragma unroll
                for (int il = 0; il < 4; ++il) aos[il] = (f32x4){0.f, 0.f, 0.f, 0.f};
#pragma unroll
                for (int ks = 0; ks < 4; ++ks) {
                    bf16x8 yf[4];
#pragma unroll
                    for (int il = 0; il < 4; ++il) yf[il] = *(const LAS bf16x8*)(Cn + (16 * il + fr) * 136 + 32 * ks + 8 * fq);
                    if (!sample) {
#pragma unroll
                        for (int il = 0; il < 4; ++il) aos[il] = __builtin_amdgcn_mfma_f32_16x16x32_bf16(sf[ks], yf[il], aos[il], 0, 0, 0);
                    }
                    if (haslp) {
#pragma unroll
                        for (int il = 0; il < 4; ++il) ao[il] = __builtin_amdgcn_mfma_f32_16x16x32_bf16(lf[ks], yf[il], ao[il], 0, 0, 0);
                    }
                }
#pragma unroll
                for (int il = 0; il < 4; ++il) ao[il] += aos[il] * cdp;
#pragma unroll
                for (int il = 0; il < 4; ++il) {
                    const float eai = ea[(16 * il + fr) * 4 + hl];
                    const u32x2 zv = zw[il];
                    const f32x4 y = ad[il] + ao[il] * eai;
                    const float g0 = y[0] * silu_f(bflo(zv.x)), g1 = y[1] * silu_f(bfhi(zv.x)), g2 = y[2] * silu_f(bflo(zv.y)), g3 = y[3] * silu_f(bfhi(zv.y));
                    ssqa[il] += (g0 * g0 + g1 * g1) + (g2 * g2 + g3 * g3);
                    u32x2 w; w.x = cvt_pk_bf16(g0 * nw4[0], g1 * nw4[1]); w.y = cvt_pk_bf16(g2 * nw4[2], g3 * nw4[3]);
                    *(u32x2*)(zp0 + (size_t)(16 * il) * LDACT) = w;
                }
            }
#pragma unroll
            for (int il = 0; il < 4; ++il) { float ssq = ssqa[il]; ssq += __shfl_xor(ssq, 16); ssq += __shfl_xor(ssq, 32); if (fq == 0) partB[wave * 64 + 16 * il + fr] = ssq; }
            __builtin_amdgcn_sched_barrier(0);
#pragma unroll
            for (int k = 0; k < 4; ++k) { ur[k + 2] = *(const u32x4*)(ACT + (size_t)(row0 + ta + k) * LDACT + ja); br[k] = *(const u32x4*)(ACT + (size_t)(row0 + ta + k) * LDACT + 1024 + ja); }
            if (ra > 0 || (!sample && !first)) {
#pragma unroll
                for (int k = 0; k < 2; ++k) ur[k] = *(const u32x4*)(ACT + (size_t)(row0 + ta - 2 + k) * LDACT + ja);
            } else if (sample) {
                const float* p = a.in[I_SCA] + (size_t)(cidx - 512) * 2 * D + ja;
#pragma unroll
                for (int k = 0; k < 2; ++k) { const f32x4 x0 = *(const f32x4*)(p + k * D), x1 = *(const f32x4*)(p + k * D + 4);
                    ur[k].x = cvt_pk_bf16(x0[0], x0[1]); ur[k].y = cvt_pk_bf16(x0[2], x0[3]); ur[k].z = cvt_pk_bf16(x1[0], x1[1]); ur[k].w = cvt_pk_bf16(x1[2], x1[3]); }
            } else { ur[0] = (u32x4){0u, 0u, 0u, 0u}; ur[1] = ur[0]; }

        }
        {
            const float* caw = a.in[I_CAW];
            f32x4 w0[2], w1[2], w2[2], nw[2];
#pragma unroll
            for (int hh = 0; hh < 2; ++hh) { w0[hh] = *(const f32x4*)(caw + ja + 4 * hh); w1[hh] = *(const f32x4*)(caw + D + ja + 4 * hh); w2[hh] = *(const f32x4*)(caw + 2 * D + ja + 4 * hh); nw[hh] = *(const f32x4*)(a.in[I_NAW] + ja + 4 * hh); }
#pragma unroll
            for (int k = 0; k < 4; ++k) {
                float y[8], ssq = 0.f;
#pragma unroll
                for (int c = 0; c < 8; ++c) {
                    const float v = rawel(br[k], c) * (w0[c >> 2][c & 3] * rawel(ur[k], c) + w1[c >> 2][c & 3] * rawel(ur[k + 1], c) + w2[c >> 2][c & 3] * rawel(ur[k + 2], c));
                    ssq += v * v; y[c] = v * nw[c >> 2][c & 3];
                }
                *(u32x4*)(ACT + (size_t)(row0 + ta + k) * LDACT + 1024 + ja) = pack8(y);
#pragma unroll
                for (int o = 1; o < 32; o <<= 1) ssq += __shfl_xor(ssq, o);
                if (ca == 0) partA[ta + k] = ssq;
            }
            if (lastc && ra == 15) {
                float* o = sample ? a.out + O_CAS + (size_t)(cidx - 512) * 2 * D + ja : a.out + O_CAP + (size_t)(cidx >> 8) * 2 * D + ja;
#pragma unroll
                for (int k = 0; k < 2; ++k) { *(f32x4*)(o + k * D) = (f32x4){rawel(ur[4 + k], 0), rawel(ur[4 + k], 1), rawel(ur[4 + k], 2), rawel(ur[4 + k], 3)};
                    *(f32x4*)(o + k * D + 4) = (f32x4){rawel(ur[4 + k], 4), rawel(ur[4 + k], 5), rawel(ur[4 + k], 6), rawel(ur[4 + k], 7)}; }
            }
        }
        __builtin_amdgcn_sched_barrier(0);
        __builtin_amdgcn_sched_barrier(0);
        P5_LOADS(unit + G < NCHUNK * 4 ? unit + G : unit);
        WG_BAR();
        if (tid < 64) { SS[(size_t)(row0 + tid) * 8 + q] = partA[tid];
            SS[(size_t)(row0 + tid) * 8 + 4 + q] = ((partB[tid] + partB[64 + tid]) + (partB[128 + tid] + partB[192 + tid])) + ((partB[256 + tid] + partB[320 + tid]) + (partB[384 + tid] + partB[448 + tid])); }
    }
}

__device__ __forceinline__ void p7_final(const Args& a, int bid, int G) {
    int tid = threadIdx.x; asm volatile("" : "+v"(tid));
    const int lane = tid & 63, wave = tid >> 6;
    f32x4 nw[4];
#pragma unroll
    for (int j = 0; j < 4; ++j) nw[j] = ((const f32x4*)a.in[I_NFW])[lane + 64 * j];
    for (int row = bid * 8 + wave; row < MT; row += G * 8) {
        f32x4* yr = (f32x4*)(a.out + (size_t)row * D);
        f32x4 v[4]; float ss = 0.f;
        if (row < MP) {
            const f32x4* xi = (const f32x4*)(a.in[I_XP] + (size_t)row * D); const u32x2* dl = (const u32x2*)((const bf16*)(a.ws + WS_DELTA) + (size_t)row * D);
#pragma unroll
            for (int j = 0; j < 4; ++j) { const u32x2 d = dl[lane + 64 * j]; v[j] = NT_LD(xi + lane + 64 * j) + (f32x4){bflo(d.x), bfhi(d.x), bflo(d.y), bfhi(d.y)}; }
        } else {
            const f32x4* xi = (const f32x4*)(a.in[I_XS] + (size_t)(row - MP) * D); const f32x4* os = (const f32x4*)(a.ws + WS_OUTS) + (size_t)(row - MP) * (D / 4);
            const f32x4* gp = (const f32x4*)((const float*)(a.ws + WS_MOD) + seq_of_row(row) * 3072 + 2048);
#pragma unroll
            for (int j = 0; j < 4; ++j) { f32x4 o = os[lane + 64 * j];
#pragma unroll
                for (int sl = 1; sl < 8; ++sl) o += os[(size_t)sl * MS * (D / 4) + lane + 64 * j];
                v[j] = xi[lane + 64 * j] + gp[lane + 64 * j] * o; }
        }
#pragma unroll
        for (int j = 0; j < 4; ++j) ss += (v[j][0] * v[j][0] + v[j][1] * v[j][1]) + (v[j][2] * v[j][2] + v[j][3] * v[j][3]);
        const float rstd = rsqrtf(wave_sum(ss) * (1.f / D) + EPS);
#pragma unroll
        for (int j = 0; j < 4; ++j) NT_ST(yr + lane + 64 * j, v[j] * rstd * nw[j]);
    }
}

#define XB_TMO      128
#define XB_XCNT(j)  (256  + 64 * (j))
#define XB_XSUB(j)  (1280 + 64 * (j))
#define XB_XGEN(j)  (2304 + 64 * (j))
#define XB_TOP      3328
#define XB_TOPGEN   3392
#define XCD_BAR_WORDS 3456
#define XB_SPIN_CAP (1u << 18)
__device__ __forceinline__ unsigned xb_ld(unsigned* p)              { return __hip_atomic_load(p, __ATOMIC_RELAXED, __HIP_MEMORY_SCOPE_AGENT); }
__device__ __forceinline__ unsigned xb_add(unsigned* p, unsigned v) { return __hip_atomic_fetch_add(p, v, __ATOMIC_RELAXED, __HIP_MEMORY_SCOPE_AGENT); }
__device__ __forceinline__ unsigned xb_xcc_id() { return (unsigned)__builtin_amdgcn_s_getreg((3 << 11) | 20) & 0xFu; }
#define XB_SPIN(cond, bar) do { unsigned _sp = 0; while (cond) { __builtin_amdgcn_s_sleep(1); \
    if ((++_sp & 255u) == 0u) { if (xb_ld(&(bar)[XB_TMO])) break; if (_sp > XB_SPIN_CAP) { atomicAdd(&(bar)[XB_TMO], 1u); break; } } } } while (0)
struct XcdBarrier { unsigned* bar; unsigned x; volatile LAS unsigned* st; };
__device__ __forceinline__ XcdBarrier xcd_barrier_post(unsigned* bar, volatile LAS unsigned* st) {
    XcdBarrier b; b.bar = bar; b.x = xb_xcc_id(); b.st = st;
    if (threadIdx.x == 0) (void)xb_add(&bar[XB_XCNT(b.x)], 1u);
    return b;
}
__device__ __forceinline__ void xcd_barrier_complete(unsigned* bar, unsigned x, unsigned& nloc, unsigned& nx) {
    const unsigned G = gridDim.x * gridDim.y * gridDim.z;
    unsigned sum, cnt, mine, sp = 0u;
    for (;;) {
        sum = 0u; cnt = 0u; mine = 0u;
#pragma unroll
        for (unsigned j = 0; j < 16; ++j) { const unsigned c = xb_ld(&bar[XB_XCNT(j)]); sum += c; cnt += (c > 0u) ? 1u : 0u; mine = (j == x) ? c : mine; }
        if (sum == G) break;
        __builtin_amdgcn_s_sleep(1);
        if ((++sp & 255u) == 0u) { if (xb_ld(&bar[XB_TMO])) break; if (sp > XB_SPIN_CAP) { atomicAdd(&bar[XB_TMO], 1u); break; } }
    }
    nloc = mine > 0u ? mine : 1u; nx = cnt > 0u ? cnt : 1u;
}
__device__ __forceinline__ void xcd_barrier(unsigned* bar_, volatile LAS unsigned* st_) {
    XcdBarrier b; b.bar = bar_; b.x = xb_xcc_id(); b.st = st_;
    asm volatile("s_waitcnt vmcnt(0)" ::: "memory");
    __syncthreads();
    if (threadIdx.x == 0) {
        unsigned* bar = b.bar;
        __builtin_amdgcn_s_waitcnt(0);
        unsigned nloc = b.st[0], nx = b.st[1];
        if (nloc == 0u) { xcd_barrier_complete(bar, b.x, nloc, nx); b.st[0] = nloc; b.st[1] = nx; }
        const unsigned old = xb_add(&bar[XB_XSUB(b.x)], 1u);
        const unsigned gen = old / nloc;
        if (old + 1u == (gen + 1u) * nloc) {
            __builtin_amdgcn_fence(__ATOMIC_RELEASE, "agent");
            asm volatile("s_waitcnt vmcnt(0)" ::: "memory");
            const unsigned og = xb_add(&bar[XB_TOP], 1u);
            const unsigned tg = og / nx;
            if (og + 1u == (tg + 1u) * nx) xb_add(&bar[XB_TOPGEN], 1u);
            else XB_SPIN(xb_ld(&bar[XB_TOPGEN]) == tg, bar);
            __builtin_amdgcn_fence(__ATOMIC_ACQUIRE, "agent");
            xb_add(&bar[XB_XGEN(b.x)], 1u);
            asm volatile("s_waitcnt vmcnt(0)" ::: "memory");
        } else {
            XB_SPIN(xb_ld(&bar[XB_XGEN(b.x)]) == gen, bar);
            __builtin_amdgcn_fence(__ATOMIC_ACQUIRE, "agent");
            asm volatile("s_waitcnt vmcnt(0)" ::: "memory");
        }
    }
    __syncthreads();
}

__global__ void __launch_bounds__(NTHREADS, 2) mk_fwd(Args a) {
    extern __shared__ __attribute__((aligned(16))) unsigned char lds_raw[];
    LAS unsigned char* lds = (LAS unsigned char*)lds_raw;
    cg::grid_group grid = cg::this_grid();
    const int bid = blockIdx.x, G = gridDim.x;
    volatile LAS unsigned* bst = (volatile LAS unsigned*)(lds + LDS_BYTES - 64);
    if (threadIdx.x < 2) bst[threadIdx.x] = 0u;
    __syncthreads();
    (void)xcd_barrier_post((unsigned*)(a.ws + WS_BAR), bst);
    if (a.pad0 != 0) grid.sync();
#define RUN_P0 p0_prologue(a, lds, bid, G)
#define RUN_P1 do { p1_transposes(a, lds, bid, G); p1_norm(a, bid, G); } while (0)
#define RUN_P2 do { pg8::Gemm g{(const bf16*)a.out, (const bf16*)(a.ws + WS_WTIN), MT, NINP, D, D}; \
        pg8::StaticOrder S; S.init(MT, NINP, D, G, bid); \
        pg8::EpiIn E{(bf16*)(a.ws + WS_ACT), (bf16*)(a.ws + WS_XBC), (float*)(a.ws + WS_DTR)}; \
        pg8::gemm_phase<pg8::EpiIn, pg8::StaticOrder>(lds, g, S, E); } while (0)
#define RUN_P3 p3_states(a, lds, bid, G)
#define RUN_P4 p4_scan(a, bid, G)
#define RUN_P5 p5_mix(a, lds, bid, G)
#define RUN_P6 do { pg8::Gemm g{(const bf16*)(a.ws + WS_ACT) + 1024, (const bf16*)(a.ws + WS_WTOUT), MT, D, 2048, LDACT}; \
        pg8::SplitOrder S; S.init(G, bid); \
        pg8::EpiOut E{(const float*)(a.ws + WS_MOD), (const float*)(a.ws + WS_SS), (bf16*)(a.ws + WS_DELTA), (float*)(a.ws + WS_OUTS)}; \
        pg8::gemm_phase<pg8::EpiOut, pg8::SplitOrder>(lds, g, S, E); } while (0)
#define RUN_P7 p7_final(a, bid, G)
#define SYNC xcd_barrier((unsigned*)(a.ws + WS_BAR), (volatile LAS unsigned*)(lds + LDS_BYTES - 64))
    RUN_P0; SYNC; RUN_P1; SYNC; RUN_P2; SYNC; RUN_P3; SYNC; RUN_P4; SYNC; RUN_P5; SYNC; RUN_P6; SYNC; RUN_P7;
}

#ifdef PROBE_LIST
template <int PH> __global__ void __launch_bounds__(NTHREADS, 2) mk_one(Args a) {
    extern __shared__ __attribute__((aligned(16))) unsigned char lds_raw[];
    LAS unsigned char* lds = (LAS unsigned char*)lds_raw;
    const int bid = blockIdx.x, G = gridDim.x;
    if constexpr (PH == 0) p0_prologue(a, lds, bid, G);
    if constexpr (PH == 1) { p1_transposes(a, lds, bid, G); p1_norm(a, bid, G); }
    if constexpr (PH == 2) { pg8::Gemm g{(const bf16*)a.out, (const bf16*)(a.ws + WS_WTIN), MT, NINP, D, D};
        pg8::StaticOrder S; S.init(MT, NINP, D, G, bid);
        pg8::EpiIn E{(bf16*)(a.ws + WS_ACT), (bf16*)(a.ws + WS_XBC), (float*)(a.ws + WS_DTR)};
        pg8::gemm_phase<pg8::EpiIn, pg8::StaticOrder>(lds, g, S, E); }
    if constexpr (PH == 3) p3_states(a, lds, bid, G);
    if constexpr (PH == 4) p4_scan(a, bid, G);
    if constexpr (PH == 5) p5_mix(a, lds, bid, G);
    if constexpr (PH == 6) { pg8::Gemm g{(const bf16*)(a.ws + WS_ACT) + 1024, (const bf16*)(a.ws + WS_WTOUT), MT, D, 2048, LDACT};
        pg8::SplitOrder S; S.init(G, bid);
        pg8::EpiOut E{(const float*)(a.ws + WS_MOD), (const float*)(a.ws + WS_SS), (bf16*)(a.ws + WS_DELTA), (float*)(a.ws + WS_OUTS)};
        pg8::gemm_phase<pg8::EpiOut, pg8::SplitOrder>(lds, g, S, E); }
    if constexpr (PH == 7) p7_final(a, bid, G);
}
template <int PH> static void launch_one(const Args& a, int grid, hipStream_t stream) {
    static bool init = false;
    if (!init) { (void)hipFuncSetAttribute((const void*)mk_one<PH>, hipFuncAttributeMaxDynamicSharedMemorySize, LDS_BYTES); init = true; }
    hipLaunchKernelGGL(mk_one<PH>, dim3(grid), dim3(NTHREADS), LDS_BYTES, stream, a);
}
#endif

extern "C" void kernel_launch(void* const* d_in, const int* in_sizes, int n_in, void* d_out, int out_size, void* d_ws, size_t ws_size, hipStream_t stream) {
    static int grid = 0;
    if (grid == 0) {
        if (n_in != 21 || out_size != (int)O_END || ws_size < WS_END) { fprintf(stderr, "kernel_launch: unexpected sizes n_in %d out %d ws %zu\n", n_in, out_size, ws_size); grid = -1; return; }
        int dev = 0, cus = 0, per_cu = 0;
        hipGetDevice(&dev);
        hipDeviceGetAttribute(&cus, hipDeviceAttributeMultiprocessorCount, dev);
        hipFuncSetAttribute((const void*)mk_fwd, hipFuncAttributeMaxDynamicSharedMemorySize, LDS_BYTES);
        hipOccupancyMaxActiveBlocksPerMultiprocessor(&per_cu, (const void*)mk_fwd, NTHREADS, LDS_BYTES);
        if (per_cu < 1) { fprintf(stderr, "kernel_launch: occupancy query says %d blocks per CU\n", per_cu); grid = -1; return; }
        grid = cus;
    }
    if (grid < 0) return;
    Args a{};
    for (int i = 0; i < 21; ++i) a.in[i] = (const float*)d_in[i];
    a.out = (float*)d_out; a.ws = (unsigned char*)d_ws;
#ifdef PROBE_LIST
    const int plist[] = PROBE_LIST;
    for (int ph : plist) {
        switch (ph) { case 0: launch_one<0>(a, grid, stream); break; case 1: launch_one<1>(a, grid, stream); break; case 2: launch_one<2>(a, grid, stream); break; case 3: launch_one<3>(a, grid, stream); break;
            case 4: launch_one<4>(a, grid, stream); break; case 5: launch_one<5>(a, grid, stream); break; case 6: launch_one<6>(a, grid, stream); break; default: launch_one<7>(a, grid, stream); break; }
    }
#else
    (void)hipMemsetAsync((char*)d_ws + WS_BAR, 0, XCD_BAR_WORDS * 4, stream);
    void* args[] = {&a};
    hipError_t e = hipLaunchCooperativeKernel((const void*)mk_fwd, dim3(grid), dim3(NTHREADS), args, LDS_BYTES, stream);
    if (e != hipSuccess) fprintf(stderr, "cooperative launch failed: %s\n", hipGetErrorString(e));
#endif
}
```
